# Optimizing an MI355X kernel written in HIP

```python
import jax, jax.numpy as jnp
from jax import lax
import numpy as np

D_MODEL = 1024
BATCH = 8
SEQ = 4096
DEPTH = 4
DEC_BATCH = 4
DEC_SEQ = 4096
PAST_LEN = 128

D_MIX = D_MODEL
ATT_HEADS = 8
Q_LORA = 256
KV_LORA = 128
NOPE_DIM = 64
ROPE_DIM = 32
V_DIM = 64
QK_DIM = NOPE_DIM + ROPE_DIM
ATT_WIDTH = ATT_HEADS * V_DIM
HG_HEADS = 4
HG_KEY = 128
HG_VAL = 128
HG_KW = HG_HEADS * HG_KEY
HG_WIDTH = HG_HEADS * HG_VAL
D_FF = 4 * D_MODEL
PLE_DIM = 256
Q_BLOCK = 128
CHUNK = 64
ROPE_THETA = 10000.0
EPS = 1e-6
IN_SIZES = (Q_LORA, KV_LORA, ROPE_DIM, HG_KW, HG_KW, HG_KW, HG_WIDTH, HG_WIDTH)
IN_COLS = sum(IN_SIZES)
IN_SPLITS = tuple(int(s) for s in np.cumsum(IN_SIZES)[:-1])

kernel_name = 'hymba_mla_hgrn2_bidir_encoder'


def rmsnorm(x, gain):
    xf = x.astype(jnp.float32)
    xf = xf * lax.rsqrt(jnp.mean(xf * xf, axis=-1, keepdims=True) + EPS)
    return (xf * gain.astype(jnp.float32)).astype(x.dtype)


def rope_tables(seq_len):
    inv = 1.0 / (ROPE_THETA ** (jnp.arange(0, ROPE_DIM, 2, dtype=jnp.float32) / ROPE_DIM))
    ang = jnp.arange(seq_len, dtype=jnp.float32)[:, None] * inv[None, :]
    return jnp.cos(ang), jnp.sin(ang)


def apply_rope(x, cos, sin):
    c = cos[None, :, None, :].astype(x.dtype)
    s = sin[None, :, None, :].astype(x.dtype)
    x1, x2 = x[..., :ROPE_DIM // 2], x[..., ROPE_DIM // 2:]
    return jnp.concatenate([x1 * c - x2 * s, x2 * c + x1 * s], axis=-1)


def mla(cq, ckv, kr, q_norm, w_uq, kv_norm, w_ukv, cos, sin):
    B, S, _ = cq.shape
    q = (rmsnorm(cq, q_norm) @ w_uq).reshape(B, S, ATT_HEADS, QK_DIM)
    q = jnp.concatenate([q[..., :NOPE_DIM], apply_rope(q[..., NOPE_DIM:], cos, sin)], axis=-1)
    q = q * jnp.asarray(QK_DIM ** -0.5, q.dtype)
    kv = (rmsnorm(ckv, kv_norm) @ w_ukv).reshape(B, S, ATT_HEADS, NOPE_DIM + V_DIM)
    k_nope, v = kv[..., :NOPE_DIM], kv[..., NOPE_DIM:]
    k_rope = apply_rope(kr[:, :, None, :], cos, sin)
    k = jnp.concatenate([k_nope, jnp.broadcast_to(k_rope, (B, S, ATT_HEADS, ROPE_DIM))], axis=-1)
    nb = S // Q_BLOCK
    qb = q.reshape(B, nb, Q_BLOCK, ATT_HEADS, QK_DIM).transpose(1, 0, 2, 3, 4)

    def block(qblk):
        s = jnp.einsum('bqhd,bkhd->bhqk', qblk, k, preferred_element_type=jnp.float32)
        p = jax.nn.softmax(s, axis=-1).astype(v.dtype)
        return jnp.einsum('bhqk,bkhd->bqhd', p, v)

    o = lax.map(block, qb)
    return o.transpose(1, 0, 2, 3, 4).reshape(B, S, ATT_WIDTH)


def hgrn_direction(q, f_pre, v, lb):
    B, S, H, K = q.shape
    V = v.shape[-1]
    nc = S // CHUNK
    lbh = lb.astype(jnp.float32).reshape(H, K)
    f = lbh + (1.0 - lbh) * jax.nn.sigmoid(f_pre.astype(jnp.float32))
    logf = jnp.log(f)
    kk = 1.0 - f

    def to_chunks(t):
        return t.astype(jnp.float32).reshape(B, nc, CHUNK, H, t.shape[-1]).transpose(1, 0, 3, 2, 4)

    xs = (to_chunks(q), to_chunks(kk), to_chunks(v), to_chunks(logf))
    mask = jnp.tril(jnp.ones((CHUNK, CHUNK), dtype=bool))[:, :, None]

    def step(state, inp):
        qc, kc, vc, gc = inp
        b = jnp.cumsum(gc, axis=2)
        diff = jnp.where(mask, b[:, :, :, None, :] - b[:, :, None, :, :], -jnp.inf)
        scores = jnp.sum(qc[:, :, :, None, :] * kc[:, :, None, :, :] * jnp.exp(diff), axis=-1)
        o = (jnp.einsum('bhts,bhsv->bhtv', scores, vc)
             + jnp.einsum('bhtk,bhkv->bhtv', qc * jnp.exp(b), state))
        b_last = b[:, :, -1:, :]
        state = (jnp.exp(b_last[:, :, 0, :])[..., None] * state
                 + jnp.einsum('bhsk,bhsv->bhkv', kc * jnp.exp(b_last - b), vc))
        return state, o

    s0 = jnp.zeros((B, H, K, V), jnp.float32)
    _, o = lax.scan(step, s0, xs)
    return o.transpose(1, 0, 3, 2, 4).reshape(B, S, H, V)


def hgrn2(hq, hf_fwd, hf_bwd, hi, hg, lb_fwd, lb_bwd, out_norm):
    B, S, _ = hq.shape
    q = jax.nn.silu(hq).reshape(B, S, HG_HEADS, HG_KEY)
    v = hi.reshape(B, S, HG_HEADS, HG_VAL)
    ff = hf_fwd.reshape(B, S, HG_HEADS, HG_KEY)
    fb = hf_bwd.reshape(B, S, HG_HEADS, HG_KEY)
    rev = lambda t: jnp.flip(t, axis=1)
    o = hgrn_direction(q, ff, v, lb_fwd) + rev(hgrn_direction(rev(q), rev(fb), rev(v), lb_bwd))
    o = rmsnorm(o, out_norm.reshape(HG_HEADS, HG_VAL)).astype(hq.dtype)
    return o.reshape(B, S, HG_WIDTH) * jax.nn.silu(hg)


def trunk(x, p, lbs, norm_mix_pre, w_in, q_norm, w_uq, kv_norm, w_ukv, att_out_norm, hg_out_norm,
          w_o, norm_mix_post, norm_mlp_pre, w_up, w_down, norm_mlp_post, w_ple, w_ple_gate, norm_ple):
    S = x.shape[1]
    cos, sin = rope_tables(S)
    for i in range(DEPTH):
        h = rmsnorm(x, norm_mix_pre[i])
        z = h @ w_in[i]
        cq, ckv, kr, hq, hff, hfb, hi, hg = jnp.split(z, IN_SPLITS, axis=-1)
        a = rmsnorm(mla(cq, ckv, kr, q_norm[i], w_uq[i], kv_norm[i], w_ukv[i], cos, sin), att_out_norm[i])
        r = hgrn2(hq, hff, hfb, hi, hg, lbs[0, i], lbs[1, i], hg_out_norm[i])
        mix = jnp.concatenate([a, r], axis=-1) @ w_o[i]
        x = x + rmsnorm(mix, norm_mix_post[i])
        h = rmsnorm(x, norm_mlp_pre[i])
        m = jnp.square(jax.nn.relu(h @ w_up[i])) @ w_down[i]
        x = x + rmsnorm(m, norm_mlp_post[i])
        e = p[i] @ w_ple[i]
        gate = jax.nn.sigmoid(x @ w_ple_gate[i])
        x = x + rmsnorm(e * gate, norm_ple[i])
    return x


def setup_inputs(seed: int = 0) -> dict:
    key = jax.random.key(seed)
    ks = jax.random.split(key, 22)
    f32 = jnp.float32

    def nrm(k, shape, scale):
        return jax.random.normal(k, shape, f32) * scale

    def gain(k, shape):
        return 1.0 + 0.01 * jax.random.normal(k, shape, f32)

    return {
        'x_prompt': nrm(ks[0], (BATCH, SEQ, D_MODEL), 1.0),
        'x_sample': nrm(ks[1], (DEC_BATCH, DEC_SEQ, D_MODEL), 1.0),
        'p_prompt': nrm(ks[2], (DEPTH, BATCH, SEQ, PLE_DIM), 1.0),
        'p_sample': nrm(ks[3], (DEPTH, DEC_BATCH, DEC_SEQ, PLE_DIM), 1.0),
        'norm_mix_pre': gain(ks[4], (DEPTH, D_MODEL)),
        'w_in': nrm(ks[5], (DEPTH, D_MODEL, IN_COLS), D_MODEL ** -0.5),
        'q_norm': gain(ks[6], (DEPTH, Q_LORA)),
        'w_uq': nrm(ks[7], (DEPTH, Q_LORA, ATT_HEADS * QK_DIM), Q_LORA ** -0.5),
        'kv_norm': gain(ks[8], (DEPTH, KV_LORA)),
        'w_ukv': nrm(ks[9], (DEPTH, KV_LORA, ATT_HEADS * (NOPE_DIM + V_DIM)), KV_LORA ** -0.5),
        'att_out_norm': gain(ks[10], (DEPTH, ATT_WIDTH)),
        'hg_lb': nrm(ks[11], (2, DEPTH, HG_KW), 0.5),
        'hg_out_norm': gain(ks[12], (DEPTH, HG_WIDTH)),
        'w_o': nrm(ks[13], (DEPTH, D_MIX, D_MODEL), D_MIX ** -0.5),
        'norm_mix_post': gain(ks[14], (DEPTH, D_MODEL)),
        'norm_mlp_pre': gain(ks[15], (DEPTH, D_MODEL)),
        'w_up': nrm(ks[16], (DEPTH, D_MODEL, D_FF), D_MODEL ** -0.5),
        'w_down': nrm(ks[17], (DEPTH, D_FF, D_MODEL), D_FF ** -0.5),
        'norm_mlp_post': gain(ks[18], (DEPTH, D_MODEL)),
        'w_ple': nrm(ks[19], (DEPTH, PLE_DIM, D_MODEL), PLE_DIM ** -0.5),
        'w_ple_gate': nrm(ks[20], (DEPTH, D_MODEL, D_MODEL), D_MODEL ** -0.5),
        'norm_ple': gain(ks[21], (DEPTH, D_MODEL)),
    }


def reference(x_prompt, x_sample, p_prompt, p_sample, norm_mix_pre, w_in, q_norm, w_uq, kv_norm, w_ukv,
              att_out_norm, hg_lb, hg_out_norm, w_o, norm_mix_post, norm_mlp_pre, w_up, w_down,
              norm_mlp_post, w_ple, w_ple_gate, norm_ple):
    lbs = jnp.cumsum(jax.nn.softmax(hg_lb.astype(jnp.float32), axis=1), axis=1)
    lbs = lbs - lbs[:, :1]
    y_prompt = trunk(x_prompt, p_prompt, lbs, norm_mix_pre, w_in, q_norm, w_uq, kv_norm, w_ukv,
                     att_out_norm, hg_out_norm, w_o, norm_mix_post, norm_mlp_pre, w_up, w_down,
                     norm_mlp_post, w_ple, w_ple_gate, norm_ple)
    y_sample = trunk(x_sample, p_sample, lbs, norm_mix_pre, w_in, q_norm, w_uq, kv_norm, w_ukv,
                     att_out_norm, hg_out_norm, w_o, norm_mix_post, norm_mlp_pre, w_up, w_down,
                     norm_mlp_post, w_ple, w_ple_gate, norm_ple)
    return (y_prompt, y_sample)
```

```cpp
#include <hip/hip_runtime.h>
#include <hip/hip_cooperative_groups.h>
#include <cstdio>
namespace cg = cooperative_groups;

#define LAS __attribute__((address_space(3)))
#define DI __device__ __forceinline__
typedef unsigned short bf16_t;
typedef short bf16x8 __attribute__((ext_vector_type(8)));
typedef float f32x4 __attribute__((ext_vector_type(4)));
typedef float f32x2 __attribute__((ext_vector_type(2)));
typedef float f32x16 __attribute__((ext_vector_type(16)));
typedef unsigned u32x4 __attribute__((ext_vector_type(4)));
typedef unsigned u32x2 __attribute__((ext_vector_type(2)));
typedef __bf16 bf2_t __attribute__((ext_vector_type(2)));

constexpr int MTOK = 49152, SEQL = 4096, NPROMPT = 32768;
constexpr float EPSN = 1e-6f;

DI unsigned pk2(float a, float b) { f32x2 v = {a, b}; return __builtin_bit_cast(unsigned, __builtin_convertvector(v, bf2_t)); }
DI float blo(unsigned w) { return __uint_as_float(w << 16); }
DI float bhi(unsigned w) { return __uint_as_float(w & 0xffff0000u); }
DI u32x4 pk8(f32x4 a, f32x4 b) { u32x4 r; r.x = pk2(a[0], a[1]); r.y = pk2(a[2], a[3]); r.z = pk2(b[0], b[1]); r.w = pk2(b[2], b[3]); return r; }
DI float sigm(float x) { return __builtin_amdgcn_rcpf(1.0f + __expf(-x)); }
DI int opaque_tid() { int t = threadIdx.x; asm volatile("" : "+v"(t)); return t; }
DI int opaque_s(int t) { asm volatile("" : "+s"(t)); return t; }
DI float wave_sum(float v) { for (int o = 32; o >= 1; o >>= 1) v += __shfl_xor(v, o); return v; }
#define MFMA32(a, b, c) __builtin_amdgcn_mfma_f32_32x32x16_bf16((a), (b), (c), 0, 0, 0)

constexpr size_t WS_WIN = 0;
constexpr size_t WS_WQKV = WS_WIN + (size_t)3072 * 1024 * 2;
constexpr size_t WS_WO = WS_WQKV + (size_t)1792 * 384 * 2;
constexpr size_t WS_WUP = WS_WO + (size_t)1024 * 1024 * 2;
constexpr size_t WS_WDN = WS_WUP + (size_t)4096 * 1024 * 2;
constexpr size_t WS_WGT = WS_WDN + (size_t)4096 * 1024 * 2;
constexpr size_t WS_WPL = WS_WGT + (size_t)1024 * 1024 * 2;
constexpr size_t WS_ROPE = WS_WPL + (size_t)1024 * 256 * 2;
constexpr size_t WS_LB = WS_ROPE + (size_t)4096 * 16 * 8;
constexpr size_t WS_SSQT = WS_LB + 2 * 4 * 512 * 4;
constexpr size_t WS_SSQQ = WS_SSQT + (size_t)MTOK * 64;
constexpr size_t WS_SSQK = WS_SSQQ + (size_t)MTOK * 16;
constexpr size_t WS_CNT = WS_SSQK + (size_t)MTOK * 16;
constexpr size_t WS_BAR = WS_CNT + 256;
constexpr size_t WS_ACT = WS_BAR + 16384;
constexpr size_t A_H = WS_ACT;
constexpr size_t A_Q = A_H + (size_t)MTOK * 2048;
constexpr size_t A_KN = A_Q + (size_t)MTOK * 1536;
constexpr size_t A_V = A_KN + (size_t)MTOK * 1024;
constexpr size_t A_HQ = A_V + (size_t)MTOK * 1024;
constexpr size_t A_GF = A_HQ + (size_t)MTOK * 1024;
constexpr size_t A_GB = A_GF + (size_t)MTOK * 1024;
constexpr size_t A_HI = A_GB + (size_t)MTOK * 1024;
constexpr size_t A_HG = A_HI + (size_t)MTOK * 1024;
constexpr size_t A_CQ = A_HG + (size_t)MTOK * 1024;
constexpr size_t A_KR = A_CQ + (size_t)MTOK * 768;
constexpr size_t WS_END = A_KR + (size_t)MTOK * 64;
constexpr size_t A_U = A_Q;
constexpr size_t A_T1 = A_Q;
constexpr size_t A_G = A_Q;
constexpr size_t A_PB = A_Q + (size_t)MTOK * 2048;
static_assert(A_U + (size_t)MTOK * 8192 <= WS_END, "u fits");

constexpr int LDS_BYTES = 131072 + 256;
#define XCD_BAR_WORDS_EARLY 3456

struct Params { const float* in[22]; float* out; unsigned char* ws; };

namespace pg8 {
constexpr int BM = 256, BK = 64, HALF = 128, HTB = HALF * BK * 2, STAGE_BYTES = 8 * HTB, NXCD = 8, WGM = 8;
DI int lds_byte(int r, int c) { const int st = (r >> 4) * 2 + (c >> 5), rr = r & 15, cc = c & 31, ob = rr * 64 + cc * 2; return st * 1024 + (ob ^ (((ob >> 9) & 1) << 5)); }
DI void stage_rc(int b, int& R, int& C) { const int st = b / 1024, sb = b % 1024, swz = sb ^ (((sb >> 9) & 1) << 5); R = (st >> 1) * 16 + swz / 64; C = (st & 1) * 32 + (swz % 64) / 2; }
DI int perm32(int rho) { const int n = rho >> 4, i = rho & 15; return 8 * (i >> 2) + 4 * n + (i & 3); }
struct Unit { int pm, pn; };
struct Gemm { const bf16_t* A; const bf16_t* Bt; int M, N, K; };
struct StaticOrder {
    int nM, nN, nwg, G, c;
    DI void init(int M, int N, int G_, int c_) { nM = M / BM; nN = N / BM; nwg = nM * nN; G = G_; c = c_; }
    DI bool next(int i, Unit& u) const {
        const long L = (long)i * G + c; if (L >= nwg) return false;
        int wgid = (int)L; { const int q = nwg / NXCD, r = nwg % NXCD, xcd = wgid % NXCD, off = wgid / NXCD; wgid = (xcd < r ? xcd * (q + 1) : r * (q + 1) + (xcd - r) * q) + off; }
        const int nig = WGM * nN, gid = wgid / nig, fm = gid * WGM, gsz = (nM - fm) < WGM ? (nM - fm) : WGM;
        u.pm = fm + ((wgid % nig) % gsz); u.pn = (wgid % nig) / gsz; return true;
    }
};
template <class Epi>
DI void gemm_phase(LAS unsigned char* lds, const Gemm g, const StaticOrder& S, const Epi& E) {
    const int tid = opaque_tid(), wid = __builtin_amdgcn_readfirstlane(tid >> 6), lane = tid & 63, wr = wid >> 2, wc = wid & 3, fr = lane & 15, fq = lane >> 4;
    const int K = g.K, nt = K / BK;
    unsigned voffA[2], voffB[2];
#pragma unroll
    for (int i = 0; i < 2; ++i) { int R, C; stage_rc(tid * 16 + i * 8192, R, C); const int Rb = (R & ~31) + perm32(R & 31);
        voffA[i] = (unsigned)(R * K + C) * 2u; voffB[i] = (unsigned)(Rb * K + C) * 2u; }
    const size_t kstep = (size_t)(BK * 2);
    const size_t hstep = (size_t)HALF * K * 2;
    const size_t tstep = 2 * hstep;
    const unsigned ldsw = (unsigned)wid * 1024u;
    const int aoff = lds_byte(wr * 64 + fr, fq * 8), boff = lds_byte(wc * 32 + fr, fq * 8);
#define PG8_SA(b, h) (((b) * 2 + (h)) * HTB)
#define PG8_SB(b, h) ((4 + (b) * 2 + (h)) * HTB)
#define PG8_STAGE(bufoff, gbase, voff) do { _Pragma("unroll") for (int _i = 0; _i < 2; ++_i) \
        __builtin_amdgcn_global_load_lds((const unsigned*)((const char*)(gbase) + (voff)[_i]), (LAS unsigned*)(lds + (bufoff) + ldsw + _i * 8192), 16, 0, 0); } while (0)
#define PG8_LDA(dst, b, h) do { _Pragma("unroll") for (int m = 0; m < 4; ++m) _Pragma("unroll") for (int k = 0; k < 2; ++k) dst[m][k] = *(const LAS bf16x8*)(lds + PG8_SA(b, h) + aoff + m * 2048 + k * 1024); } while (0)
#define PG8_LDB(dst, b, h) do { _Pragma("unroll") for (int n = 0; n < 2; ++n) _Pragma("unroll") for (int k = 0; k < 2; ++k) dst[n][k] = *(const LAS bf16x8*)(lds + PG8_SB(b, h) + boff + n * 2048 + k * 1024); } while (0)
#define PG8_MMA(ai, bj, At, Bt) do { __builtin_amdgcn_s_setprio(1); _Pragma("unroll") for (int m = 0; m < 4; ++m) _Pragma("unroll") for (int n = 0; n < 2; ++n) _Pragma("unroll") for (int k = 0; k < 2; ++k) \
        acc[ai][bj][m][n] = __builtin_amdgcn_mfma_f32_16x16x32_bf16(Bt[n][k], At[m][k], acc[ai][bj][m][n], 0, 0, 0); __builtin_amdgcn_s_setprio(0); } while (0)
#define PG8_WAIT_V(n) asm volatile("s_waitcnt vmcnt(" #n ")" ::: "memory")
#define PG8_WAIT_L(n) asm volatile("s_waitcnt lgkmcnt(" #n ")" ::: "memory")
#define PG8_BAR __builtin_amdgcn_s_barrier()
#define PG8_SCHED __builtin_amdgcn_sched_barrier(0)
    Unit cur, nxt; int ui = 0;
    if (!S.next(0, cur)) return;
    f32x4 acc[2][2][4][2];
#pragma unroll
    for (int a = 0; a < 2; ++a)
#pragma unroll
        for (int b = 0; b < 2; ++b)
#pragma unroll
            for (int m = 0; m < 4; ++m)
#pragma unroll
                for (int n = 0; n < 2; ++n) acc[a][b][m][n] = (f32x4){0.f, 0.f, 0.f, 0.f};
    bf16x8 At[4][2], B0[2][2], B1[2][2];
    const char* cA = (const char*)g.A + (size_t)cur.pm * tstep; const char* cB = (const char*)g.Bt + (size_t)cur.pn * tstep;
    PG8_STAGE(PG8_SB(0, 0), cB, voffB); PG8_STAGE(PG8_SA(0, 0), cA, voffA); PG8_STAGE(PG8_SB(0, 1), cB + hstep, voffB); PG8_STAGE(PG8_SA(0, 1), cA + hstep, voffA);
    if (wr == 1) PG8_BAR;
    PG8_WAIT_V(4); PG8_BAR;
    PG8_STAGE(PG8_SB(1, 0), cB + kstep, voffB); PG8_STAGE(PG8_SA(1, 0), cA + kstep, voffA); PG8_STAGE(PG8_SB(1, 1), cB + hstep + kstep, voffB);
    PG8_WAIT_V(6); PG8_BAR;
    for (;;) {
        const bool has_next = S.next(ui + 1, nxt);
        const char* nA = has_next ? (const char*)g.A + (size_t)nxt.pm * tstep : cA; const char* nB = has_next ? (const char*)g.Bt + (size_t)nxt.pn * tstep : cB;
        for (int t = 0; t < nt; t += 2) {
            const bool last = (t == nt - 2);
            const char* a1 = cA + (size_t)(t + 1) * kstep;
            const char* a2 = last ? nA : cA + (size_t)(t + 2) * kstep; const char* b2 = last ? nB : cB + (size_t)(t + 2) * kstep;
            const char* a3 = a2 + kstep; const char* b3 = b2 + kstep;
            PG8_LDB(B0, 0, 0); PG8_SCHED; PG8_LDA(At, 0, 0); PG8_STAGE(PG8_SA(1, 1), a1 + hstep, voffA);
            PG8_WAIT_L(8); PG8_BAR; PG8_WAIT_L(0); PG8_MMA(0, 0, At, B0); PG8_BAR; PG8_SCHED;
            PG8_LDB(B1, 0, 1); PG8_STAGE(PG8_SB(0, 0), b2, voffB);
            PG8_BAR; PG8_WAIT_L(0); PG8_MMA(0, 1, At, B1); PG8_BAR;
            PG8_LDA(At, 0, 1); PG8_STAGE(PG8_SA(0, 0), a2, voffA);
            PG8_BAR; PG8_WAIT_L(0); PG8_MMA(1, 0, At, B0); PG8_BAR; PG8_SCHED;
            PG8_STAGE(PG8_SB(0, 1), b2 + hstep, voffB);
            PG8_WAIT_V(6); PG8_BAR; PG8_MMA(1, 1, At, B1); PG8_BAR;
            PG8_LDB(B0, 1, 0); PG8_SCHED; PG8_LDA(At, 1, 0); PG8_STAGE(PG8_SA(0, 1), a2 + hstep, voffA);
            PG8_WAIT_L(8); PG8_BAR; PG8_WAIT_L(0); PG8_MMA(0, 0, At, B0); PG8_BAR; PG8_SCHED;
            PG8_LDB(B1, 1, 1); PG8_STAGE(PG8_SB(1, 0), b3, voffB);
            PG8_BAR; PG8_WAIT_L(0); PG8_MMA(0, 1, At, B1); PG8_BAR;
            PG8_LDA(At, 1, 1); PG8_STAGE(PG8_SA(1, 0), a3, voffA);
            PG8_BAR; PG8_WAIT_L(0); PG8_MMA(1, 0, At, B0); PG8_BAR; PG8_SCHED;
            PG8_STAGE(PG8_SB(1, 1), b3 + hstep, voffB);
            PG8_WAIT_V(6); PG8_BAR; PG8_MMA(1, 1, At, B1); PG8_BAR;
        }
        E(acc, cur, wr, wc, fr, fq);
        if (!has_next) break;
#pragma unroll
        for (int a = 0; a < 2; ++a)
#pragma unroll
            for (int b = 0; b < 2; ++b)
#pragma unroll
                for (int m = 0; m < 4; ++m)
#pragma unroll
                    for (int n = 0; n < 2; ++n) acc[a][b][m][n] = (f32x4){0.f, 0.f, 0.f, 0.f};
        cur = nxt; cA = nA; cB = nB; ++ui;
    }
    PG8_WAIT_V(0);
    if (wr == 0) PG8_BAR;
    PG8_BAR;
#undef PG8_SA
#undef PG8_SB
#undef PG8_STAGE
#undef PG8_LDA
#undef PG8_LDB
#undef PG8_MMA
#undef PG8_WAIT_V
#undef PG8_WAIT_L
#undef PG8_BAR
#undef PG8_SCHED
}
}
typedef f32x4 Acc[2][2][4][2];

struct EpiIn {
    bf16_t *cq, *kr, *hq, *gf, *gb, *hi, *hg; float *ssq_q, *ssq_kv; const f32x2* rope; const float* lb; int layer;
    DI void operator()(const Acc& acc, const pg8::Unit& u, int wr, int wc, int fr, int fq) const {
        asm volatile("" : "+v"(fr), "+v"(fq));
        const int row0 = u.pm * 256 + wr * 64 + fr, cw = wc * 32 + 8 * fq, pn = u.pn;
        if (pn == 0) {
#pragma unroll
            for (int ai = 0; ai < 2; ++ai)
#pragma unroll
                for (int m = 0; m < 4; ++m) { const int row = row0 + ai * 128 + m * 16; float ss = 0.f;
#pragma unroll
                    for (int bj = 0; bj < 2; ++bj) { const f32x4 v0 = acc[ai][bj][m][0], v1 = acc[ai][bj][m][1];
                        *(u32x4*)(cq + (size_t)row * 384 + bj * 128 + cw) = pk8(v0, v1);
                        ss += v0[0] * v0[0] + v0[1] * v0[1] + v0[2] * v0[2] + v0[3] * v0[3] + v1[0] * v1[0] + v1[1] * v1[1] + v1[2] * v1[2] + v1[3] * v1[3]; }
                    ss += __shfl_xor(ss, 16); ss += __shfl_xor(ss, 32);
                    if (fq == 0) ssq_q[row * 4 + wc] = ss; }
        } else if (pn == 1) {
#pragma unroll
            for (int ai = 0; ai < 2; ++ai)
#pragma unroll
                for (int m = 0; m < 4; ++m) { const int row = row0 + ai * 128 + m * 16;
                    { const f32x4 v0 = acc[ai][0][m][0], v1 = acc[ai][0][m][1];
                      *(u32x4*)(cq + (size_t)row * 384 + 256 + cw) = pk8(v0, v1);
                      float ss = v0[0] * v0[0] + v0[1] * v0[1] + v0[2] * v0[2] + v0[3] * v0[3] + v1[0] * v1[0] + v1[1] * v1[1] + v1[2] * v1[2] + v1[3] * v1[3];
                      ss += __shfl_xor(ss, 16); ss += __shfl_xor(ss, 32);
                      if (fq == 0) ssq_kv[row * 4 + wc] = ss; }
                    if (wc == 0) { const f32x4 x1 = acc[ai][1][m][0], x2 = acc[ai][1][m][1]; const int pos = row & (SEQL - 1); f32x4 o1, o2;
#pragma unroll
                        for (int j = 0; j < 4; ++j) { const f32x2 cs = rope[pos * 16 + 4 * fq + j]; o1[j] = x1[j] * cs.x - x2[j] * cs.y; o2[j] = x2[j] * cs.x + x1[j] * cs.y; }
                        *(u32x4*)(kr + (size_t)row * 32 + 8 * fq) = pk8(o1, o2); }
                    asm volatile("" ::: "memory"); }
        } else {
            const int seg = (pn - 2) >> 1, cb = ((pn - 2) & 1) * 256;
            bf16_t* dst = seg == 0 ? hq : seg == 1 ? gf : seg == 2 ? gb : seg == 3 ? hi : hg;
#pragma unroll
            for (int bj = 0; bj < 2; ++bj) { const int col = cb + bj * 128 + cw;
                f32x4 l0 = {0.f, 0.f, 0.f, 0.f}, l1 = l0;
                if (seg == 1 || seg == 2) { const float* lp = lb + ((seg - 1) * 4 + layer) * 512 + col; l0 = *(const f32x4*)lp; l1 = *(const f32x4*)(lp + 4); }
#pragma unroll
                for (int ai = 0; ai < 2; ++ai)
#pragma unroll
                    for (int m = 0; m < 4; ++m) { const int row = row0 + ai * 128 + m * 16; f32x4 v0 = acc[ai][bj][m][0], v1 = acc[ai][bj][m][1];
                        if (seg == 0 || seg == 4) {
#pragma unroll
                            for (int j = 0; j < 4; ++j) { v0[j] = v0[j] * sigm(v0[j]); v1[j] = v1[j] * sigm(v1[j]); }
                        } else if (seg == 1 || seg == 2) {
#pragma unroll
                            for (int j = 0; j < 4; ++j) { v0[j] = fmaxf(__logf(l0[j] + (1.0f - l0[j]) * sigm(v0[j])), -30.0f); v1[j] = fmaxf(__logf(l1[j] + (1.0f - l1[j]) * sigm(v1[j])), -30.0f); }
                        }
                        *(u32x4*)(dst + (size_t)row * 512 + col) = pk8(v0, v1); } }
        }
    }
};
struct EpiQkv {
    bf16_t *q, *kn, *v; const float *ssq_q, *ssq_kv; const f32x2* rope;
    DI void operator()(const Acc& acc, const pg8::Unit& u, int wr, int wc, int fr, int fq) const {
        asm volatile("" : "+v"(fr), "+v"(fq));
        const int row0 = u.pm * 256 + wr * 64 + fr, cw = wc * 32 + 8 * fq, pn = u.pn;
        const float qsc = 0.10206207261596575f * 1.4426950408889634f;
#pragma unroll
        for (int ai = 0; ai < 2; ++ai)
#pragma unroll
            for (int m = 0; m < 4; ++m) { const int row = row0 + ai * 128 + m * 16;
                if (pn <= 2) { const f32x4 sq4 = *(const f32x4*)(ssq_q + row * 4); const float rq = rsqrtf(((sq4[0] + sq4[1]) + (sq4[2] + sq4[3])) * (1.0f / 256.0f) + EPSN) * qsc;
                    if (pn < 2) {
#pragma unroll
                        for (int bj = 0; bj < 2; ++bj) { const int colg = pn * 256 + bj * 128 + cw, head = colg >> 6, d = colg & 63;
                            *(u32x4*)(q + (size_t)row * 768 + head * 96 + d) = pk8(acc[ai][bj][m][0] * rq, acc[ai][bj][m][1] * rq); }
                    } else { const int pos = row & (SEQL - 1);
#pragma unroll
                        for (int bj = 0; bj < 2; ++bj) { const int head = 4 * bj + wc; const f32x4 x1 = acc[ai][bj][m][0] * rq, x2 = acc[ai][bj][m][1] * rq; f32x4 o1, o2;
#pragma unroll
                            for (int j = 0; j < 4; ++j) { const f32x2 cs = rope[pos * 16 + 4 * fq + j]; o1[j] = x1[j] * cs.x - x2[j] * cs.y; o2[j] = x2[j] * cs.x + x1[j] * cs.y; }
                            *(u32x4*)(q + (size_t)row * 768 + head * 96 + 64 + 8 * fq) = pk8(o1, o2); }
                    }
                } else { const f32x4 sk4 = *(const f32x4*)(ssq_kv + row * 4); const float rk = rsqrtf(((sk4[0] + sk4[1]) + (sk4[2] + sk4[3])) * (1.0f / 128.0f) + EPSN);
                    bf16_t* dst = pn < 5 ? kn : v; const int cb = ((pn - 3) & 1) * 256;
#pragma unroll
                    for (int bj = 0; bj < 2; ++bj) *(u32x4*)(dst + (size_t)row * 512 + cb + bj * 128 + cw) = pk8(acc[ai][bj][m][0] * rk, acc[ai][bj][m][1] * rk);
                }
                asm volatile("" ::: "memory"); }
    }
};
struct EpiT {
    bf16_t* t; float* ssq; const bf16_t* gate;
    DI void operator()(const Acc& acc, const pg8::Unit& u, int wr, int wc, int fr, int fq) const {
        asm volatile("" : "+v"(fr), "+v"(fq));
        const int row0 = u.pm * 256 + wr * 64 + fr, c0 = u.pn * 256 + wc * 32 + 8 * fq;
#pragma unroll
        for (int ai = 0; ai < 2; ++ai)
#pragma unroll
            for (int m = 0; m < 4; ++m) { const int row = row0 + ai * 128 + m * 16; float ss = 0.f;
#pragma unroll
                for (int bj = 0; bj < 2; ++bj) { f32x4 v0 = acc[ai][bj][m][0], v1 = acc[ai][bj][m][1]; const size_t off = (size_t)row * 1024 + c0 + bj * 128;
                    if (gate) { const u32x4 gw = *(const u32x4*)(gate + off);
                        v0[0] *= blo(gw.x); v0[1] *= bhi(gw.x); v0[2] *= blo(gw.y); v0[3] *= bhi(gw.y); v1[0] *= blo(gw.z); v1[1] *= bhi(gw.z); v1[2] *= blo(gw.w); v1[3] *= bhi(gw.w); }
                    *(u32x4*)(t + off) = pk8(v0, v1);
                    ss += v0[0] * v0[0] + v0[1] * v0[1] + v0[2] * v0[2] + v0[3] * v0[3] + v1[0] * v1[0] + v1[1] * v1[1] + v1[2] * v1[2] + v1[3] * v1[3]; }
                ss += __shfl_xor(ss, 16); ss += __shfl_xor(ss, 32);
                if (fq == 0) ssq[row * 16 + u.pn * 4 + wc] = ss;
                asm volatile("" ::: "memory"); }
    }
};
template <int ACT> struct EpiAct {
    bf16_t* o; int ldc;
    DI void operator()(const Acc& acc, const pg8::Unit& u, int wr, int wc, int fr, int fq) const {
        asm volatile("" : "+v"(fr), "+v"(fq));
        const int row0 = u.pm * 256 + wr * 64 + fr, c0 = u.pn * 256 + wc * 32 + 8 * fq;
#pragma unroll
        for (int ai = 0; ai < 2; ++ai)
#pragma unroll
            for (int m = 0; m < 4; ++m) { const int row = row0 + ai * 128 + m * 16;
#pragma unroll
                for (int bj = 0; bj < 2; ++bj) { f32x4 v0 = acc[ai][bj][m][0], v1 = acc[ai][bj][m][1];
#pragma unroll
                    for (int j = 0; j < 4; ++j) {
                        if (ACT == 0) { const float a = fmaxf(v0[j], 0.f), b = fmaxf(v1[j], 0.f); v0[j] = a * a; v1[j] = b * b; }
                        else { v0[j] = sigm(v0[j]); v1[j] = sigm(v1[j]); } }
                    *(u32x4*)(o + (size_t)row * ldc + c0 + bj * 128) = pk8(v0, v1); } }
    }
};

template <class Epi> DI void run_gemm(LAS unsigned char* lds, const bf16_t* A, const bf16_t* Bt, int N, int K, const Epi& E) {
    pg8::Gemm g{A, Bt, MTOK, opaque_s(N), opaque_s(K)}; pg8::StaticOrder S; S.init(MTOK, g.N, opaque_s((int)gridDim.x), opaque_s((int)blockIdx.x));
    pg8::gemm_phase<Epi>(lds, g, S, E);
}

DI int rope_dim(int p) { return 16 * ((p & 7) >> 2) + 4 * (p >> 3) + (p & 3); }
DI int map_in(int n) {
    if (n < 384) return n;
    if (n < 416) return 384 + rope_dim(n - 384);
    if (n < 512) return -1;
    if (n < 1024) return 416 + (n - 512);
    if (n < 1536) return 928 + (n - 1024);
    if (n < 2048) return 1440 + (n - 1536);
    if (n < 2560) return 1952 + (n - 2048);
    return 2464 + (n - 2560);
}
DI float wsrc(const Params& P, int job, int L, int n, int k) {
    switch (job) {
    case 0: { const int c = map_in(n); return c < 0 ? 0.f : P.in[5][((size_t)L * 1024 + k) * 2976 + c] * P.in[4][L * 1024 + k]; }
    case 1: {
        if (n < 768) { if (k >= 256) return 0.f;
            int c; if (n < 512) c = (n >> 6) * 96 + (n & 63); else { const int mm = n - 512; c = (mm >> 5) * 96 + 64 + rope_dim(mm & 31); }
            return P.in[7][((size_t)L * 256 + k) * 768 + c] * P.in[6][L * 256 + k]; }
        if (k < 256) return 0.f;
        const int kk = k - 256; int mm = n - 768, c; if (mm < 512) c = (mm >> 6) * 128 + (mm & 63); else { mm -= 512; c = (mm >> 6) * 128 + 64 + (mm & 63); }
        return P.in[9][((size_t)L * 128 + kk) * 1024 + c] * P.in[8][L * 128 + kk]; }
    case 2: return P.in[13][((size_t)L * 1024 + k) * 1024 + n];
    case 3: return P.in[16][((size_t)L * 1024 + k) * 4096 + n] * P.in[15][L * 1024 + k];
    case 4: return P.in[17][((size_t)L * 4096 + k) * 1024 + n];
    case 5: return P.in[20][((size_t)L * 1024 + k) * 1024 + n];
    default: return P.in[19][((size_t)L * 256 + k) * 1024 + n];
    }
}
DI void prep_weights(const Params& P, LAS unsigned char* lds, int L, unsigned char* wb, int t0, int t1, int tstride) {
    const int tid = opaque_tid();
    LAS bf16_t* tile = (LAS bf16_t*)lds;
    for (int ti = t0; ti < t1; ti += tstride) {
        int job, t = ti, NT, Kout; size_t dst;
        if (t < 768) { job = 0; NT = 48; Kout = 1024; dst = WS_WIN; }
        else if ((t -= 768) < 168) { job = 1; NT = 28; Kout = 384; dst = WS_WQKV; }
        else if ((t -= 168) < 256) { job = 2; NT = 16; Kout = 1024; dst = WS_WO; }
        else if ((t -= 256) < 1024) { job = 3; NT = 64; Kout = 1024; dst = WS_WUP; }
        else if ((t -= 1024) < 1024) { job = 4; NT = 16; Kout = 4096; dst = WS_WDN; }
        else if ((t -= 1024) < 256) { job = 5; NT = 16; Kout = 1024; dst = WS_WGT; }
        else { t -= 256; job = 6; NT = 16; Kout = 256; dst = WS_WPL; }
        const int n0 = (t % NT) * 64, k0 = (t / NT) * 64;
        { const int nn = tid & 63, kk = tid >> 6;
#pragma unroll
          for (int i = 0; i < 8; ++i) { const int k = kk + 8 * i; const float v = wsrc(P, job, L, n0 + nn, k0 + k); tile[nn * 72 + k] = (bf16_t)(pk2(v, 0.f) & 0xffffu); } }
        __syncthreads();
        { const int n = tid >> 3, kc = tid & 7; const u32x4 w = *(const LAS u32x4*)(tile + n * 72 + kc * 8);
          *(u32x4*)((bf16_t*)(wb + dst) + (size_t)(n0 + n) * Kout + k0 + kc * 8) = w; }
        __syncthreads();
    }
}
DI void prep_tables(const Params& P) {
    const int gt = opaque_s(blockIdx.x) * 512 + opaque_tid(), nth = opaque_s(gridDim.x) * 512;
    f32x2* rope = (f32x2*)(P.ws + WS_ROPE);
    for (int idx = gt; idx < 4096 * 16; idx += nth) { const int pos = idx >> 4, i = idx & 15;
        const float inv = exp2f(-(float)i * (13.287712379549449f / 16.0f)); const float a = (float)pos * inv;
        const float n = rintf(a * 0.15915494309189535f); float r = fmaf(-n, 6.2831854820251465f, a); r = fmaf(-n, -1.7484555e-7f, r);
        rope[idx] = (f32x2){__cosf(r), __sinf(r)}; }
    float* lbs = (float*)(P.ws + WS_LB);
    for (int idx = gt; idx < 1024; idx += nth) { const int dir = idx >> 9, col = idx & 511; float v[4], mx = -1e30f, sum = 0.f;
        for (int l = 0; l < 4; ++l) { v[l] = P.in[11][(dir * 4 + l) * 512 + col]; mx = fmaxf(mx, v[l]); }
        for (int l = 0; l < 4; ++l) { v[l] = __expf(v[l] - mx); sum += v[l]; }
        float cum = 0.f; lbs[(dir * 4) * 512 + col] = 0.f;
        for (int l = 1; l < 4; ++l) { cum += v[l] / sum; lbs[(dir * 4 + l) * 512 + col] = cum; } }
    unsigned* cnt = (unsigned*)(P.ws + WS_CNT);
    if (gt < 64) cnt[gt] = 0u;
    unsigned* barw = (unsigned*)(P.ws + WS_BAR);
    for (int idx = gt; idx < XCD_BAR_WORDS_EARLY; idx += nth) barw[idx] = 0u;
}

typedef _Float16 h2_t __attribute__((ext_vector_type(2)));
DI unsigned pkh2(float a, float b) { f32x2 v = {a, b}; return __builtin_bit_cast(unsigned, __builtin_convertvector(v, h2_t)); }
DI f32x2 unh2(unsigned w) { return __builtin_convertvector(__builtin_bit_cast(h2_t, w), f32x2); }
DI void norm_phase(const Params& P, int mode, int layer, const float* gain, const bf16_t* T, bf16_t* out2, int norm_out, int fin = 0, int rev = 0) {
    const int tid_ = opaque_tid(); const int lane = tid_ & 63, gw = opaque_s(blockIdx.x) * 8 + (tid_ >> 6), nw = opaque_s(gridDim.x) * 8;
    const float* ssq_t = (const float*)(P.ws + WS_SSQT);
    bf16_t* pb = (bf16_t*)(P.ws + A_PB);
    unsigned short* X16 = (unsigned short*)(P.ws + A_H);
    constexpr int RU = 2;
    for (int row0 = gw; row0 < MTOK; row0 += RU * nw) {
        f32x4 xv[RU][4]; u32x2 tw[RU][4]; float sq[RU]; f32x4 pv[RU];
#pragma unroll
        for (int r = 0; r < RU; ++r) { const int rrow = row0 + r * nw; const int row = rev ? MTOK - 1 - rrow : rrow; if (rrow < MTOK) {
            if (mode == 0) { const float* xs = row < NPROMPT ? P.in[0] + (size_t)row * 1024 : P.in[1] + (size_t)(row - NPROMPT) * 1024;
#pragma unroll
                for (int i = 0; i < 4; ++i) xv[r][i] = *(const f32x4*)(xs + (i * 64 + lane) * 4);
            } else {
#pragma unroll
                for (int i = 0; i < 4; ++i) { const u32x2 xw = __builtin_nontemporal_load((const u32x2*)(X16 + (size_t)row * 1024 + (i * 64 + lane) * 4)); const f32x2 a = unh2(xw.x), c = unh2(xw.y); xv[r][i] = (f32x4){a.x, a.y, c.x, c.y}; }
                sq[r] = lane < 16 ? ssq_t[row * 16 + lane] : 0.f;
#pragma unroll
                for (int i = 0; i < 4; ++i) tw[r][i] = __builtin_nontemporal_load((const u32x2*)(T + (size_t)row * 1024 + (i * 64 + lane) * 4)); }
            if (mode == 2) { const float* pp = row < NPROMPT ? P.in[2] + ((size_t)layer * NPROMPT + row) * 256 : P.in[3] + ((size_t)layer * (MTOK - NPROMPT) + (row - NPROMPT)) * 256;
                pv[r] = *(const f32x4*)(pp + lane * 4); } } }
#pragma unroll
        for (int r = 0; r < RU; ++r) { const int rrow = row0 + r * nw; const int row = rev ? MTOK - 1 - rrow : rrow; if (rrow < MTOK) {
            if (mode != 0) { const float rs = rsqrtf(wave_sum(sq[r]) * (1.0f / 1024.0f) + EPSN);
#pragma unroll
                for (int i = 0; i < 4; ++i) { const f32x4 g4 = *(const f32x4*)(gain + (i * 64 + lane) * 4);
                    xv[r][i][0] += blo(tw[r][i].x) * rs * g4[0]; xv[r][i][1] += bhi(tw[r][i].x) * rs * g4[1]; xv[r][i][2] += blo(tw[r][i].y) * rs * g4[2]; xv[r][i][3] += bhi(tw[r][i].y) * rs * g4[3]; } }
            if (fin) {
#pragma unroll
                for (int i = 0; i < 4; ++i) *(f32x4*)(P.out + (size_t)row * 1024 + (i * 64 + lane) * 4) = xv[r][i];
            } else {
                float ss = 0.f;
#pragma unroll
                for (int i = 0; i < 4; ++i) ss += xv[r][i][0] * xv[r][i][0] + xv[r][i][1] * xv[r][i][1] + xv[r][i][2] * xv[r][i][2] + xv[r][i][3] * xv[r][i][3];
                ss = wave_sum(ss);
                const float rx = norm_out ? rsqrtf(ss * (1.0f / 1024.0f) + EPSN) : 1.0f;
#pragma unroll
                for (int i = 0; i < 4; ++i) { u32x2 xw; xw.x = pkh2(xv[r][i][0], xv[r][i][1]); xw.y = pkh2(xv[r][i][2], xv[r][i][3]);
                    __builtin_nontemporal_store(xw, (u32x2*)(X16 + (size_t)row * 1024 + (i * 64 + lane) * 4));
                    u32x2 w; w.x = pk2(xv[r][i][0] * rx, xv[r][i][1] * rx); w.y = pk2(xv[r][i][2] * rx, xv[r][i][3] * rx);
                    *(u32x2*)(out2 + (size_t)row * 1024 + (i * 64 + lane) * 4) = w; }
                if (mode == 2) { u32x2 w; w.x = pk2(pv[r][0], pv[r][1]); w.y = pk2(pv[r][2], pv[r][3]); *(u32x2*)(pb + (size_t)row * 256 + lane * 4) = w; } } } }
    }
}
DI void combine_phase(const Params& P, int layer) {
    const int tid_ = opaque_tid(); const int lane = tid_ & 63, gw = opaque_s(blockIdx.x) * 8 + (tid_ >> 6), nw = opaque_s(gridDim.x) * 8;
    const bf16_t* Q = (const bf16_t*)(P.ws + A_Q); bf16_t* H = (bf16_t*)P.out; const bf16_t* HG = (const bf16_t*)(P.ws + A_HG);
    const float* g1 = P.in[10] + layer * 512 + lane * 8; const float* g2 = P.in[12] + layer * 512 + lane * 8;
    const f32x4 ga0 = *(const f32x4*)g1, ga1 = *(const f32x4*)(g1 + 4), gb0 = *(const f32x4*)g2, gb1 = *(const f32x4*)(g2 + 4);
    constexpr int RU = 2;
    for (int row0 = gw; row0 < MTOK; row0 += RU * nw) {
        u32x4 aw[RU], fw[RU], bw[RU], gw4[RU];
#pragma unroll
        for (int r = 0; r < RU; ++r) { const int row = row0 + r * nw; if (row < MTOK) {
            aw[r] = *(const u32x4*)(Q + (size_t)row * 768 + (lane >> 3) * 96 + (lane & 7) * 8);
            fw[r] = *(const u32x4*)(H + (size_t)row * 1024 + lane * 8); bw[r] = *(const u32x4*)(H + (size_t)row * 1024 + 512 + lane * 8);
            gw4[r] = *(const u32x4*)(HG + (size_t)row * 512 + lane * 8); } }
#pragma unroll
        for (int r = 0; r < RU; ++r) { const int row = row0 + r * nw; if (row < MTOK) {
            f32x4 a0 = {blo(aw[r].x), bhi(aw[r].x), blo(aw[r].y), bhi(aw[r].y)}, a1 = {blo(aw[r].z), bhi(aw[r].z), blo(aw[r].w), bhi(aw[r].w)};
            f32x4 o0 = {blo(fw[r].x) + blo(bw[r].x), bhi(fw[r].x) + bhi(bw[r].x), blo(fw[r].y) + blo(bw[r].y), bhi(fw[r].y) + bhi(bw[r].y)};
            f32x4 o1 = {blo(fw[r].z) + blo(bw[r].z), bhi(fw[r].z) + bhi(bw[r].z), blo(fw[r].w) + blo(bw[r].w), bhi(fw[r].w) + bhi(bw[r].w)};
            float sa = a0[0] * a0[0] + a0[1] * a0[1] + a0[2] * a0[2] + a0[3] * a0[3] + a1[0] * a1[0] + a1[1] * a1[1] + a1[2] * a1[2] + a1[3] * a1[3];
            float so = o0[0] * o0[0] + o0[1] * o0[1] + o0[2] * o0[2] + o0[3] * o0[3] + o1[0] * o1[0] + o1[1] * o1[1] + o1[2] * o1[2] + o1[3] * o1[3];
            sa = wave_sum(sa);
            so += __shfl_xor(so, 1); so += __shfl_xor(so, 2); so += __shfl_xor(so, 4); so += __shfl_xor(so, 8);
            const float ra = rsqrtf(sa * (1.0f / 512.0f) + EPSN), ro = rsqrtf(so * (1.0f / 128.0f) + EPSN);
            const f32x4 h0 = {blo(gw4[r].x), bhi(gw4[r].x), blo(gw4[r].y), bhi(gw4[r].y)}, h1 = {blo(gw4[r].z), bhi(gw4[r].z), blo(gw4[r].w), bhi(gw4[r].w)};
            *(u32x4*)(H + (size_t)row * 1024 + lane * 8) = pk8(a0 * ra * ga0, a1 * ra * ga1);
            *(u32x4*)(H + (size_t)row * 1024 + 512 + lane * 8) = pk8(o0 * ro * gb0 * h0, o1 * ro * gb1 * h1); } }
    }
}

template <bool SAFE> DI bool attn_item(const Params& P, LAS unsigned char* lds, int b, int head, int qblk, bool do_store = true) {
    const int tid = opaque_tid(), lane = tid & 63, wid = __builtin_amdgcn_readfirstlane(tid >> 6), l31 = lane & 31, hh = lane >> 5;
    bf16_t* Qg = (bf16_t*)(P.ws + A_Q); const bf16_t* KN = (const bf16_t*)(P.ws + A_KN); const bf16_t* KR = (const bf16_t*)(P.ws + A_KR); const bf16_t* Vg = (const bf16_t*)(P.ws + A_V);
    const size_t seq0 = (size_t)b * SEQL;
    const size_t qrow = seq0 + qblk * 256 + wid * 32 + l31;
    bf16x8 bq[6];
    { const bf16_t* qp = Qg + qrow * 768 + head * 96 + 8 * hh;
#pragma unroll
      for (int s = 0; s < 6; ++s) bq[s] = __builtin_nontemporal_load((const bf16x8*)(qp + 16 * s)); }
    f32x16 o0, o1;
#pragma unroll
    for (int i = 0; i < 16; ++i) { o0[i] = 0.f; o1[i] = 0.f; }
    float mrun = -1e30f, lsum = 0.f;
    const int kkey = tid >> 3, kc = tid & 7, rkey = (tid & 255) >> 2, rc = tid & 3;
    const bf16_t* kn_g = KN + (seq0 + kkey) * 512 + head * 64 + kc * 8;
    const bf16_t* kr_g = KR + (seq0 + rkey) * 32 + rc * 8;
    const bf16_t* v_g = Vg + (seq0 + kkey) * 512 + head * 64 + kc * 8;
    const int trq = (lane & 15) >> 2, trp = lane & 3, trd = 16 * ((lane >> 4) & 1);
    u32x4 rk = *(const u32x4*)kn_g, rr = *(const u32x4*)kr_g, rv = *(const u32x4*)v_g;
#define ATT_KS(buf) ((LAS bf16_t*)(lds + (buf) * 13312))
#define ATT_VT(buf) ((LAS bf16_t*)(lds + 26624 + (buf) * 12288))
#define ATT_WRITE(buf) do { \
        *(LAS u32x4*)(ATT_KS(buf) + kkey * 104 + kc * 8) = rk; \
        if (tid < 256) *(LAS u32x4*)(ATT_KS(buf) + rkey * 104 + 64 + rc * 8) = rr; \
        *(LAS u32x4*)(ATT_VT(buf) + kkey * 96 + kc * 8) = rv; } while (0)
    ATT_WRITE(0);
    __syncthreads();
#pragma unroll 1
    for (int t = 0; t < 64; ++t) {
        const int cur = t & 1;
        if (t + 1 < 64) { const size_t adv = (size_t)(t + 1) * 64;
            rk = *(const u32x4*)(kn_g + adv * 512); rr = *(const u32x4*)(kr_g + adv * 32); rv = *(const u32x4*)(v_g + adv * 512); }
        const LAS bf16_t* Ks = ATT_KS(cur); const LAS bf16_t* Vt = ATT_VT(cur);
        f32x16 s0, s1;
#pragma unroll
        for (int i = 0; i < 16; ++i) { s0[i] = 0.f; s1[i] = 0.f; }
        bf16x8 ka0[6], ka1[6];
#pragma unroll
        for (int s = 0; s < 6; ++s) { ka0[s] = *(const LAS bf16x8*)(Ks + l31 * 104 + 16 * s + 8 * hh); ka1[s] = *(const LAS bf16x8*)(Ks + (32 + l31) * 104 + 16 * s + 8 * hh); }
        __builtin_amdgcn_sched_barrier(0);
#pragma unroll
        for (int s = 0; s < 6; ++s) { s0 = MFMA32(ka0[s], bq[s], s0); s1 = MFMA32(ka1[s], bq[s], s1); }
        typedef short s16x4 __attribute__((ext_vector_type(4)));
        bf16x8 vf0[4], vf1[4];
#pragma unroll
        for (int f = 0; f < 4; ++f) { const int keyb = 32 * (f >> 1) + 16 * (f & 1) + 4 * hh;
            { const s16x4 lo = __builtin_amdgcn_ds_read_tr16_b64_v4i16((LAS s16x4*)(Vt + (keyb + trq) * 96 + trd + 4 * trp)), hi = __builtin_amdgcn_ds_read_tr16_b64_v4i16((LAS s16x4*)(Vt + (keyb + 8 + trq) * 96 + trd + 4 * trp));
              vf0[f] = __builtin_shufflevector(lo, hi, 0, 1, 2, 3, 4, 5, 6, 7); }
            { const s16x4 lo = __builtin_amdgcn_ds_read_tr16_b64_v4i16((LAS s16x4*)(Vt + (keyb + trq) * 96 + 32 + trd + 4 * trp)), hi = __builtin_amdgcn_ds_read_tr16_b64_v4i16((LAS s16x4*)(Vt + (keyb + 8 + trq) * 96 + 32 + trd + 4 * trp));
              vf1[f] = __builtin_shufflevector(lo, hi, 0, 1, 2, 3, 4, 5, 6, 7); } }
        __builtin_amdgcn_sched_barrier(0);
        if (SAFE) {
            float mx = s0[0];
#pragma unroll
            for (int i = 1; i < 16; ++i) mx = fmaxf(mx, s0[i]);
#pragma unroll
            for (int i = 0; i < 16; ++i) mx = fmaxf(mx, s1[i]);
            mx = fmaxf(mx, __shfl_xor(mx, 32));
            const float mnew = fmaxf(mrun, mx), alpha = __builtin_amdgcn_exp2f(mrun - mnew); mrun = mnew;
            float ps = 0.f;
#pragma unroll
            for (int i = 0; i < 16; ++i) { s0[i] = __builtin_amdgcn_exp2f(s0[i] - mnew); s1[i] = __builtin_amdgcn_exp2f(s1[i] - mnew); ps += s0[i] + s1[i]; }
            lsum = lsum * alpha + ps;
#pragma unroll
            for (int i = 0; i < 16; ++i) { o0[i] *= alpha; o1[i] *= alpha; }
        } else {
            float ps = 0.f;
#pragma unroll
            for (int i = 0; i < 16; ++i) { s0[i] = __builtin_amdgcn_exp2f(s0[i]); s1[i] = __builtin_amdgcn_exp2f(s1[i]); ps += s0[i] + s1[i]; }
            lsum += ps;
        }
#pragma unroll
        for (int kb = 0; kb < 2; ++kb)
#pragma unroll
            for (int sg = 0; sg < 2; ++sg) {
                u32x4 pw;
                if (kb == 0) { pw.x = pk2(s0[8 * sg + 0], s0[8 * sg + 1]); pw.y = pk2(s0[8 * sg + 2], s0[8 * sg + 3]); pw.z = pk2(s0[8 * sg + 4], s0[8 * sg + 5]); pw.w = pk2(s0[8 * sg + 6], s0[8 * sg + 7]); }
                else { pw.x = pk2(s1[8 * sg + 0], s1[8 * sg + 1]); pw.y = pk2(s1[8 * sg + 2], s1[8 * sg + 3]); pw.z = pk2(s1[8 * sg + 4], s1[8 * sg + 5]); pw.w = pk2(s1[8 * sg + 6], s1[8 * sg + 7]); }
                const bf16x8 pb = __builtin_bit_cast(bf16x8, pw);
                o0 = MFMA32(vf0[2 * kb + sg], pb, o0); o1 = MFMA32(vf1[2 * kb + sg], pb, o1);
            }
        if (t + 1 < 64) ATT_WRITE(cur ^ 1);
        __syncthreads();
    }
    lsum += __shfl_xor(lsum, 32);
    if (!SAFE) { const int bad = !(lsum > 1e-30f && lsum < 1e30f); if (__syncthreads_or(bad)) return true; }
    const float inv = 1.0f / lsum;
    bf16_t* op = do_store ? Qg + qrow * 768 + head * 96 + 4 * hh : (bf16_t*)(P.ws + A_CQ) + qrow * 384 + (head & 3) * 64 + 4 * hh;
#pragma unroll
    for (int g = 0; g < 4; ++g) {
        u32x2 w0, w1;
        w0.x = pk2(o0[4 * g] * inv, o0[4 * g + 1] * inv); w0.y = pk2(o0[4 * g + 2] * inv, o0[4 * g + 3] * inv);
        w1.x = pk2(o1[4 * g] * inv, o1[4 * g + 1] * inv); w1.y = pk2(o1[4 * g + 2] * inv, o1[4 * g + 3] * inv);
        *(u32x2*)(op + 8 * g) = w0; *(u32x2*)(op + 32 + 8 * g) = w1;
    }
#undef ATT_KS
#undef ATT_VT
#undef ATT_WRITE
    return false;
}

DI void hgrn_chain(const Params& P, LAS unsigned char* lds, int b, int head, int dir) {
    typedef short s16x4 __attribute__((ext_vector_type(4)));
    const int tid = opaque_tid(), lane = tid & 63, wid = __builtin_amdgcn_readfirstlane(tid >> 6), l31 = lane & 31, hh = lane >> 5;
#define HB(buf) (lds + (buf) * 38400)
    const bf16_t* gq = (const bf16_t*)(P.ws + A_HQ); const bf16_t* gg = (const bf16_t*)(P.ws + (dir ? A_GB : A_GF)); const bf16_t* gv = (const bf16_t*)(P.ws + A_HI);
    bf16_t* go = (bf16_t*)P.out + (dir ? 512 : 0);
    const size_t seq0 = (size_t)b * SEQL;
#define HG_TOK(c, tau) (dir ? (SEQL - 1 - ((c) * 32 + (tau))) : ((c) * 32 + (tau)))
#define HG_BAR() do { asm volatile("s_waitcnt lgkmcnt(0)" ::: "memory"); __builtin_amdgcn_s_barrier(); asm volatile("" ::: "memory"); } while (0)
    if (wid < 4) {
        const int kp16 = lane & 15, part = lane >> 4, k0 = 2 * (16 * wid + kp16), vt = tid & 31, vc = tid >> 5;
        unsigned rg[8], rq[8]; u32x4 rv0, rv1;
#define HG_LOAD(c1, G, Q, V0, V1) do { \
            _Pragma("unroll") for (int t_ = 0; t_ < 8; ++t_) { const size_t a_ = (seq0 + HG_TOK(c1, 8 * part + t_)) * 512 + head * 128 + k0; G[t_] = __builtin_nontemporal_load((const unsigned*)(gg + a_)); Q[t_] = __builtin_nontemporal_load((const unsigned*)(gq + a_)); } \
            { const bf16_t* vp_ = gv + (seq0 + HG_TOK(c1, vt)) * 512 + head * 128 + 16 * vc; V0 = __builtin_nontemporal_load((const u32x4*)vp_); V1 = __builtin_nontemporal_load((const u32x4*)(vp_ + 8)); } } while (0)
        HG_LOAD(0, rg, rq, rv0, rv1);
#pragma unroll 1
        for (int c1 = 0; c1 < 128; ++c1) {
            unsigned ng[8], nq[8]; u32x4 nv0, nv1;
            if (c1 + 1 < 128) HG_LOAD(c1 + 1, ng, nq, nv0, nv1);
            LAS unsigned char* hb = HB(c1 & 1);
            LAS bf16_t* Qt = (LAS bf16_t*)hb; LAS bf16_t* Kt = (LAS bf16_t*)(hb + 8704); LAS bf16_t* KdT = (LAS bf16_t*)(hb + 17408); LAS bf16_t* Vs = (LAS bf16_t*)(hb + 27648); LAS float* dec = (LAS float*)(hb + 37888);
            float csA[8], csB[8], tA = 0.f, tB = 0.f;
#pragma unroll
            for (int i = 0; i < 8; ++i) { tA += blo(rg[i]); tB += bhi(rg[i]); csA[i] = tA; csB[i] = tB; }
            float offA = 0.f, offB = 0.f, totA = 0.f, totB = 0.f;
#pragma unroll
            for (int pp = 0; pp < 4; ++pp) { const float a_ = __shfl(tA, kp16 + 16 * pp), b_ = __shfl(tB, kp16 + 16 * pp); totA += a_; totB += b_; offA += (pp < part) ? a_ : 0.f; offB += (pp < part) ? b_ : 0.f; }
            float kdA[8], kdB[8];
#pragma unroll
            for (int i = 0; i < 8; ++i) {
                const float bA = offA + csA[i], bB = offB + csB[i];
                const float eA = __expf(bA), eB = __expf(bB), kkA = 1.0f - __expf(blo(rg[i])), kkB = 1.0f - __expf(bhi(rg[i]));
                const int tau = 8 * part + i;
                *(LAS unsigned*)(Qt + tau * 136 + k0) = pk2(blo(rq[i]) * eA, bhi(rq[i]) * eB);
                *(LAS unsigned*)(Kt + tau * 136 + k0) = pk2(kkA * __expf(fminf(-bA, 80.0f)), kkB * __expf(fminf(-bB, 80.0f)));
                kdA[i] = kkA * __expf(totA - bA); kdB[i] = kkB * __expf(totB - bB);
            }
            { u32x4 w0, w1; w0.x = pk2(kdA[0], kdA[1]); w0.y = pk2(kdA[2], kdA[3]); w0.z = pk2(kdA[4], kdA[5]); w0.w = pk2(kdA[6], kdA[7]);
              w1.x = pk2(kdB[0], kdB[1]); w1.y = pk2(kdB[2], kdB[3]); w1.z = pk2(kdB[4], kdB[5]); w1.w = pk2(kdB[6], kdB[7]);
              *(LAS u32x4*)(KdT + k0 * 40 + 8 * part) = w0; *(LAS u32x4*)(KdT + (k0 + 1) * 40 + 8 * part) = w1; }
            if (part == 0) { dec[k0] = __expf(totA); dec[k0 + 1] = __expf(totB); }
            *(LAS u32x4*)(Vs + vt * 160 + 16 * vc) = rv0; *(LAS u32x4*)(Vs + vt * 160 + 16 * vc + 8) = rv1;
            if (c1 + 1 < 128) {
#pragma unroll
                for (int t_ = 0; t_ < 8; ++t_) { rg[t_] = ng[t_]; rq[t_] = nq[t_]; }
                rv0 = nv0; rv1 = nv1; }
            HG_BAR();
        }
        HG_BAR();
#undef HG_LOAD
    } else {
        const int vb = wid - 4;
        const int trq = (lane & 15) >> 2, trp = lane & 3, trd = 16 * ((lane >> 4) & 1);
        f32x16 X0, X1, X2, X3;
#pragma unroll
        for (int i = 0; i < 16; ++i) { X0[i] = 0.f; X1[i] = 0.f; X2[i] = 0.f; X3[i] = 0.f; }
        HG_BAR();
#pragma unroll 1
        for (int c = 0; c < 128; ++c) {
            const LAS unsigned char* hb = HB(c & 1);
            const LAS bf16_t* Qt = (const LAS bf16_t*)hb; const LAS bf16_t* Kt = (const LAS bf16_t*)(hb + 8704); const LAS bf16_t* KdT = (const LAS bf16_t*)(hb + 17408); const LAS bf16_t* Vs = (const LAS bf16_t*)(hb + 27648); const LAS float* dec = (const LAS float*)(hb + 37888);
            f32x16 pt, O;
#pragma unroll
            for (int i = 0; i < 16; ++i) { pt[i] = 0.f; O[i] = 0.f; }
#pragma unroll
            for (int ks = 0; ks < 8; ++ks) { const bf16x8 a = *(const LAS bf16x8*)(Kt + l31 * 136 + 16 * ks + 8 * hh), bqv = *(const LAS bf16x8*)(Qt + l31 * 136 + 16 * ks + 8 * hh); pt = MFMA32(a, bqv, pt); }
#define HG_SQ(X, kb) do { _Pragma("unroll") for (int sg = 0; sg < 2; ++sg) { u32x4 xw; xw.x = pk2(X[8 * sg], X[8 * sg + 1]); xw.y = pk2(X[8 * sg + 2], X[8 * sg + 3]); xw.z = pk2(X[8 * sg + 4], X[8 * sg + 5]); xw.w = pk2(X[8 * sg + 6], X[8 * sg + 7]); \
                const LAS bf16_t* qp_ = Qt + l31 * 136 + 32 * (kb) + 16 * sg + 4 * hh; const u32x2 lo_ = *(const LAS u32x2*)qp_, hi_ = *(const LAS u32x2*)(qp_ + 8); \
                const u32x4 bw_ = {lo_.x, lo_.y, hi_.x, hi_.y}; O = MFMA32(__builtin_bit_cast(bf16x8, xw), __builtin_bit_cast(bf16x8, bw_), O); } } while (0)
            HG_SQ(X0, 0); HG_SQ(X1, 1); HG_SQ(X2, 2); HG_SQ(X3, 3);
#undef HG_SQ
#pragma unroll
            for (int r = 0; r < 16; ++r) { const int srow = (r & 3) + 8 * (r >> 2) + 4 * hh; pt[r] = (srow <= l31) ? pt[r] : 0.f; }
#pragma unroll
            for (int sg = 0; sg < 2; ++sg) { u32x4 pw; pw.x = pk2(pt[8 * sg], pt[8 * sg + 1]); pw.y = pk2(pt[8 * sg + 2], pt[8 * sg + 3]); pw.z = pk2(pt[8 * sg + 4], pt[8 * sg + 5]); pw.w = pk2(pt[8 * sg + 6], pt[8 * sg + 7]);
                const LAS bf16_t* vp = Vs + (16 * sg + 4 * hh + trq) * 160 + 32 * vb + trd + 4 * trp;
                const s16x4 lo = __builtin_amdgcn_ds_read_tr16_b64_v4i16((LAS s16x4*)vp), hi = __builtin_amdgcn_ds_read_tr16_b64_v4i16((LAS s16x4*)(vp + 8 * 160));
                O = MFMA32(__builtin_shufflevector(lo, hi, 0, 1, 2, 3, 4, 5, 6, 7), __builtin_bit_cast(bf16x8, pw), O); }
            bf16x8 vfr[2];
#pragma unroll
            for (int sg = 0; sg < 2; ++sg) { const LAS bf16_t* vp = Vs + (16 * sg + 8 * hh + trq) * 160 + 32 * vb + trd + 4 * trp;
                const s16x4 lo = __builtin_amdgcn_ds_read_tr16_b64_v4i16((LAS s16x4*)vp), hi = __builtin_amdgcn_ds_read_tr16_b64_v4i16((LAS s16x4*)(vp + 4 * 160));
                vfr[sg] = __builtin_shufflevector(lo, hi, 0, 1, 2, 3, 4, 5, 6, 7); }
#define HG_UP(X, kb) do { _Pragma("unroll") for (int g = 0; g < 4; ++g) { const f32x4 d4 = *(const LAS f32x4*)(dec + 32 * (kb) + 8 * g + 4 * hh); \
                    X[4 * g] *= d4[0]; X[4 * g + 1] *= d4[1]; X[4 * g + 2] *= d4[2]; X[4 * g + 3] *= d4[3]; } \
                _Pragma("unroll") for (int sg = 0; sg < 2; ++sg) { const bf16x8 a_ = *(const LAS bf16x8*)(KdT + (32 * (kb) + l31) * 40 + 16 * sg + 8 * hh); X = MFMA32(a_, vfr[sg], X); } } while (0)
            HG_UP(X0, 0); HG_UP(X1, 1); HG_UP(X2, 2); HG_UP(X3, 3);
#undef HG_UP
            { bf16_t* op = go + (seq0 + HG_TOK(c, l31)) * 1024 + head * 128 + 32 * vb + 4 * hh;
#pragma unroll
              for (int g = 0; g < 4; ++g) { u32x2 w; w.x = pk2(O[4 * g], O[4 * g + 1]); w.y = pk2(O[4 * g + 2], O[4 * g + 3]); *(u32x2*)(op + 8 * g) = w; } }
            HG_BAR();
        }
    }
#undef HB
#undef HG_TOK
#undef HG_BAR
}

DI void mixer_phase(const Params& P, LAS unsigned char* lds, int layer, unsigned char* wnext, int probe = 0) {
    unsigned* cnt = (unsigned*)(P.ws + WS_CNT) + (probe ? layer + 4 : layer) * 8;
    LAS unsigned* slot = (LAS unsigned*)(lds + 131072);
    const int xq0 = opaque_s(blockIdx.x) & 7;
    for (int rr = 0; rr < 8; ++rr) {
        const int xq = (xq0 + rr) & 7;
        for (;;) {
            if (threadIdx.x == 0) *slot = atomicAdd(cnt + xq, 1u);
            __syncthreads();
            const unsigned i = *slot;
            __syncthreads();
            if (i >= 204u) { if (wnext == nullptr || probe != 0 || i >= 268u) break;
                const int pi = xq * 64 + (int)(i - 204u);
                prep_weights(P, lds, layer + 1, wnext, pi * 7, (pi * 7 + 7) < 3560 ? (pi * 7 + 7) : 3560, 1);
                continue; }
            if (i < 12u) { if (probe != 2) { const int ci = xq * 12 + (int)i; hgrn_chain(P, lds, ci >> 3, (ci >> 1) & 3, ci & 1); } }
            else { if (probe != 1) { const int j = (int)i - 12, pair = xq * 12 + (j >> 4); if (attn_item<false>(P, lds, pair >> 3, pair & 7, j & 15, probe == 0)) { __syncthreads(); attn_item<true>(P, lds, pair >> 3, pair & 7, j & 15, probe == 0); } } }
            __syncthreads();
        }
    }
}


#define XB_TMO      128
#define XB_XCNT(j)  (256  + 64 * (j))
#define XB_XSUB(j)  (1280 + 64 * (j))
#define XB_XGEN(j)  (2304 + 64 * (j))
#define XB_TOP      3328
#define XB_TOPGEN   3392
#define XCD_BAR_WORDS 3456
#define XB_SPIN_CAP (1u << 18)
DI unsigned xb_ld(unsigned* p) { return __hip_atomic_load(p, __ATOMIC_RELAXED, __HIP_MEMORY_SCOPE_AGENT); }
DI unsigned xb_add(unsigned* p, unsigned v) { return __hip_atomic_fetch_add(p, v, __ATOMIC_RELAXED, __HIP_MEMORY_SCOPE_AGENT); }
DI unsigned xb_xcc_id() { return (unsigned)__builtin_amdgcn_s_getreg((3 << 11) | 20) & 0xFu; }
#define XB_SPIN(cond, bar) do { unsigned _sp = 0; while (cond) { __builtin_amdgcn_s_sleep(1); \
    if ((++_sp & 255u) == 0u) { if (xb_ld(&(bar)[XB_TMO])) break; if (_sp > XB_SPIN_CAP) { atomicAdd(&(bar)[XB_TMO], 1u); break; } } } } while (0)
struct XcdBarrier { unsigned* bar; unsigned x; volatile LAS unsigned* st; };
DI XcdBarrier xcd_barrier_post(unsigned* bar, volatile LAS unsigned* st) {
    XcdBarrier b; b.bar = bar; b.x = xb_xcc_id(); b.st = st;
    if (threadIdx.x == 0) (void)xb_add(&bar[XB_XCNT(b.x)], 1u);
    return b;
}
DI void xcd_barrier_complete(unsigned* bar, unsigned x, unsigned& nloc, unsigned& nx) {
    const unsigned G = gridDim.x * gridDim.y * gridDim.z;
    unsigned sum, cnt, mine, sp = 0u;
    for (;;) {
        sum = 0u; cnt = 0u; mine = 0u;
#pragma unroll
        for (unsigned j = 0; j < 16; ++j) { const unsigned c = xb_ld(&bar[XB_XCNT(j)]); sum += c; cnt += (c > 0u) ? 1u : 0u; mine = (j == x) ? c : mine; }
        if (sum == G) break;
        __builtin_amdgcn_s_sleep(1);
        if ((++sp & 255u) == 0u) { if (xb_ld(&bar[XB_TMO])) break; if (sp > XB_SPIN_CAP) { atomicAdd(&bar[XB_TMO], 1u); break; } }
    }
    nloc = mine > 0u ? mine : 1u; nx = cnt > 0u ? cnt : 1u;
}
DI void xcd_barrier(const XcdBarrier& b) {
    asm volatile("s_waitcnt vmcnt(0)" ::: "memory");
    __syncthreads();
    if (threadIdx.x == 0) {
        unsigned* bar = b.bar;
        __builtin_amdgcn_s_waitcnt(0);
        unsigned nloc = b.st[0], nx = b.st[1];
        if (nloc == 0u) { xcd_barrier_complete(bar, b.x, nloc, nx); b.st[0] = nloc; b.st[1] = nx; }
        const unsigned old = xb_add(&bar[XB_XSUB(b.x)], 1u);
        const unsigned gen = old / nloc;
        if (old + 1u == (gen + 1u) * nloc) {
            __builtin_amdgcn_fence(__ATOMIC_RELEASE, "agent");
            asm volatile("s_waitcnt vmcnt(0)" ::: "memory");
            const unsigned og = xb_add(&bar[XB_TOP], 1u);
            const unsigned tg = og / nx;
            if (og + 1u == (tg + 1u) * nx) xb_add(&bar[XB_TOPGEN], 1u);
            else XB_SPIN(xb_ld(&bar[XB_TOPGEN]) == tg, bar);
            __builtin_amdgcn_fence(__ATOMIC_ACQUIRE, "agent");
            xb_add(&bar[XB_XGEN(b.x)], 1u);
            asm volatile("s_waitcnt vmcnt(0)" ::: "memory");
        } else {
            XB_SPIN(xb_ld(&bar[XB_XGEN(b.x)]) == gen, bar);
            __builtin_amdgcn_fence(__ATOMIC_ACQUIRE, "agent");
            asm volatile("s_waitcnt vmcnt(0)" ::: "memory");
        }
    }
    __syncthreads();
}

__global__ void __launch_bounds__(512) fwd_kernel(Params P) {
    extern __shared__ __attribute__((aligned(16))) unsigned char shm[];
    LAS unsigned char* lds = (LAS unsigned char*)shm;
    cg::grid_group grid = cg::this_grid();
    unsigned char* ws = P.ws;
    bf16_t* H = (bf16_t*)P.out;
    float* ssq_t = (float*)(ws + WS_SSQT); float* ssq_q = (float*)(ws + WS_SSQQ); float* ssq_k = (float*)(ws + WS_SSQK);
    const f32x2* rope = (const f32x2*)(ws + WS_ROPE);

    volatile LAS unsigned* xst = (volatile LAS unsigned*)(lds + 131072 + 16);
    if (threadIdx.x < 2) xst[threadIdx.x] = 0u;
    __syncthreads();
    prep_tables(P);
    norm_phase(P, 0, 0, nullptr, nullptr, H, 1);
    unsigned char* const wimg1 = (unsigned char*)P.out + (size_t)MTOK * 2048;
    prep_weights(P, lds, 0, ws, opaque_s(blockIdx.x), 3560, opaque_s(gridDim.x));
    grid.sync();
    const XcdBarrier xb = xcd_barrier_post((unsigned*)(ws + WS_BAR), xst);
#define GSYNC() xcd_barrier(xb)
#pragma unroll 1
    for (int layer = 0; layer < 4; ++layer) {
        if (layer > 0) GSYNC();
        const unsigned char* wb = (layer & 1) ? wimg1 : ws;
        unsigned char* wnext = layer < 3 ? ((layer & 1) ? ws : wimg1) : nullptr;
        { EpiIn E{(bf16_t*)(ws + A_CQ), (bf16_t*)(ws + A_KR), (bf16_t*)(ws + A_HQ), (bf16_t*)(ws + A_GF), (bf16_t*)(ws + A_GB), (bf16_t*)(ws + A_HI), (bf16_t*)(ws + A_HG),
                  ssq_q, ssq_k, rope, (const float*)(ws + WS_LB), layer};
          run_gemm(lds, H, (const bf16_t*)(wb + WS_WIN), 3072, 1024, E); }
        GSYNC();
        { EpiQkv E{(bf16_t*)(ws + A_Q), (bf16_t*)(ws + A_KN), (bf16_t*)(ws + A_V), ssq_q, ssq_k, rope};
          run_gemm(lds, (const bf16_t*)(ws + A_CQ), (const bf16_t*)(wb + WS_WQKV), 1792, 384, E); }
        GSYNC();
#ifdef PROBE_DUP
        mixer_phase(P, lds, layer, nullptr, PROBE_DUP);
        GSYNC();
#endif
        mixer_phase(P, lds, layer, wnext);
        GSYNC();
        combine_phase(P, layer);
        GSYNC();
        { EpiT E{(bf16_t*)(ws + A_T1), ssq_t, nullptr};
          run_gemm(lds, H, (const bf16_t*)(wb + WS_WO), 1024, 1024, E); }
        GSYNC();
        norm_phase(P, 1, layer, P.in[14] + layer * 1024, (const bf16_t*)(ws + A_T1), H, 1, 0, (1 + layer * 3) & 1);
        GSYNC();
        { EpiAct<0> E{(bf16_t*)(ws + A_U), 4096};
          run_gemm(lds, H, (const bf16_t*)(wb + WS_WUP), 4096, 1024, E); }
        GSYNC();
        { EpiT E{H, ssq_t, nullptr};
          run_gemm(lds, (const bf16_t*)(ws + A_U), (const bf16_t*)(wb + WS_WDN), 1024, 4096, E); }
        GSYNC();
        norm_phase(P, 2, layer, P.in[18] + layer * 1024, H, H, 0, 0, (2 + layer * 3) & 1);
        GSYNC();
        { EpiAct<1> E{(bf16_t*)(ws + A_G), 1024};
          run_gemm(lds, H, (const bf16_t*)(wb + WS_WGT), 1024, 1024, E); }
        GSYNC();
        bf16_t* Tl = layer < 3 ? H : (bf16_t*)(ws + A_V);
        { EpiT E{Tl, ssq_t, (const bf16_t*)(ws + A_G)};
          run_gemm(lds, (const bf16_t*)(ws + A_PB), (const bf16_t*)(wb + WS_WPL), 1024, 256, E); }
        GSYNC();
        norm_phase(P, 3, layer, P.in[21] + layer * 1024, Tl, H, 1, layer == 3, (3 + layer * 3) & 1);
    }
}

extern "C" void kernel_launch(void* const* d_in, const int* in_sizes, int n_in, void* d_out, int out_size, void* d_ws, size_t ws_size, hipStream_t stream) {
    static int grid_blocks = 0;
    if (grid_blocks == 0) {
        if (n_in != 22 || out_size != MTOK * 1024 || ws_size < WS_END) { fprintf(stderr, "kernel_launch: unexpected shapes (n_in %d out %d ws %zu need %zu)\n", n_in, out_size, ws_size, (size_t)WS_END); grid_blocks = -1; return; }
        int dev = 0, cus = 0, per_cu = 0;
        hipGetDevice(&dev);
        hipDeviceGetAttribute(&cus, hipDeviceAttributeMultiprocessorCount, dev);
        if (hipFuncSetAttribute((const void*)fwd_kernel, hipFuncAttributeMaxDynamicSharedMemorySize, LDS_BYTES) != hipSuccess) { fprintf(stderr, "kernel_launch: hipFuncSetAttribute failed\n"); grid_blocks = -1; return; }
        hipOccupancyMaxActiveBlocksPerMultiprocessor(&per_cu, (const void*)fwd_kernel, 512, LDS_BYTES);
        if (per_cu < 1) { fprintf(stderr, "kernel_launch: occupancy query says %d blocks/CU\n", per_cu); per_cu = 1; }
        (void)hipGetLastError();
        grid_blocks = cus;
    }
    if (grid_blocks < 0) return;
    Params p{};
    for (int i = 0; i < 22; ++i) p.in[i] = (const float*)d_in[i];
    p.out = (float*)d_out; p.ws = (unsigned char*)d_ws;
    void* args[] = {&p};
    hipError_t e = hipLaunchCooperativeKernel((const void*)fwd_kernel, dim3(grid_blocks), dim3(512), args, LDS_BYTES, stream);
    if (e != hipSuccess) fprintf(stderr, "cooperative launch failed: %s (grid %d)\n", hipGetErrorString(e), grid_blocks);
}
```

```cpp
#include <hip/hip_runtime.h>
#include <hip/hip_cooperative_groups.h>
#include <cstdio>
namespace cg = cooperative_groups;

#define LAS __attribute__((address_space(3)))
#define DI __device__ __forceinline__
typedef unsigned short bf16_t;
typedef short bf16x8 __attribute__((ext_vector_type(8)));
typedef float f32x4 __attribute__((ext_vector_type(4)));
typedef float f32x2 __attribute__((ext_vector_type(2)));
typedef float f32x16 __attribute__((ext_vector_type(16)));
typedef unsigned u32x4 __attribute__((ext_vector_type(4)));
typedef unsigned u32x2 __attribute__((ext_vector_type(2)));
typedef __bf16 bf2_t __attribute__((ext_vector_type(2)));

constexpr int MTOK = 49152, SEQL = 4096, NPROMPT = 32768;
constexpr float EPSN = 1e-6f;

DI unsigned pk2(float a, float b) { f32x2 v = {a, b}; return __builtin_bit_cast(unsigned, __builtin_convertvector(v, bf2_t)); }
DI float blo(unsigned w) { return __uint_as_float(w << 16); }
DI float bhi(unsigned w) { return __uint_as_float(w & 0xffff0000u); }
DI u32x4 pk8(f32x4 a, f32x4 b) { u32x4 r; r.x = pk2(a[0], a[1]); r.y = pk2(a[2], a[3]); r.z = pk2(b[0], b[1]); r.w = pk2(b[2], b[3]); return r; }
DI float sigm(float x) { return __builtin_amdgcn_rcpf(1.0f + __expf(-x)); }
DI int opaque_tid() { int t = threadIdx.x; asm volatile("" : "+v"(t)); return t; }
DI int opaque_s(int t) { asm volatile("" : "+s"(t)); return t; }
DI float wave_sum(float v) { for (int o = 32; o >= 1; o >>= 1) v += __shfl_xor(v, o); return v; }
#define MFMA32(a, b, c) __builtin_amdgcn_mfma_f32_32x32x16_bf16((a), (b), (c), 0, 0, 0)

constexpr size_t WS_WIN = 0;
constexpr size_t WS_WQKV = WS_WIN + (size_t)3072 * 1024 * 2;
constexpr size_t WS_WO = WS_WQKV + (size_t)1792 * 384 * 2;
constexpr size_t WS_WUP = WS_WO + (size_t)1024 * 1024 * 2;
constexpr size_t WS_WDN = WS_WUP + (size_t)4096 * 1024 * 2;
constexpr size_t WS_WGT = WS_WDN + (size_t)4096 * 1024 * 2;
constexpr size_t WS_WPL = WS_WGT + (size_t)1024 * 1024 * 2;
constexpr size_t WS_ROPE = WS_WPL + (size_t)1024 * 256 * 2;
constexpr size_t WS_LB = WS_ROPE + (size_t)4096 * 16 * 8;
constexpr size_t WS_SSQT = WS_LB + 2 * 4 * 512 * 4;
constexpr size_t WS_SSQQ = WS_SSQT + (size_t)MTOK * 64;
constexpr size_t WS_SSQK = WS_SSQQ + (size_t)MTOK * 16;
constexpr size_t WS_CNT = WS_SSQK + (size_t)MTOK * 16;
constexpr size_t WS_BAR = WS_CNT + 256;
constexpr size_t WS_ACT = WS_BAR + 16384;
constexpr size_t A_H = WS_ACT;
constexpr size_t A_Q = A_H + (size_t)MTOK * 2048;
constexpr size_t A_KN = A_Q + (size_t)MTOK * 1536;
constexpr size_t A_V = A_KN + (size_t)MTOK * 1024;
constexpr size_t A_HQ = A_V + (size_t)MTOK * 1024;
constexpr size_t A_GF = A_HQ + (size_t)MTOK * 1024;
constexpr size_t A_GB = A_GF + (size_t)MTOK * 1024;
constexpr size_t A_HI = A_GB + (size_t)MTOK * 1024;
constexpr size_t A_HG = A_HI + (size_t)MTOK * 1024;
constexpr size_t A_CQ = A_HG + (size_t)MTOK * 1024;
constexpr size_t A_KR = A_CQ + (size_t)MTOK * 768;
constexpr size_t WS_END = A_KR + (size_t)MTOK * 64;
constexpr size_t A_U = A_Q;
constexpr size_t A_T1 = A_Q;
constexpr size_t A_G = A_Q;
constexpr size_t A_PB = A_Q + (size_t)MTOK * 2048;
static_assert(A_U + (size_t)MTOK * 8192 <= WS_END, "u fits");

constexpr int LDS_BYTES = 131072 + 256;
#define XCD_BAR_WORDS_EARLY 3456

struct Params { const float* in[22]; float* out; unsigned char* ws; };

namespace pg8 {
constexpr int BM = 256, BK = 64, HALF = 128, HTB = HALF * BK * 2, STAGE_BYTES = 8 * HTB, NXCD = 8, WGM = 8;
DI int lds_byte(int r, int c) { const int st = (r >> 4) * 2 + (c >> 5), rr = r & 15, cc = c & 31, ob = rr * 64 + cc * 2; return st * 1024 + (ob ^ (((ob >> 9) & 1) << 5)); }
DI void stage_rc(int b, int& R, int& C) { const int st = b / 1024, sb = b % 1024, swz = sb ^ (((sb >> 9) & 1) << 5); R = (st >> 1) * 16 + swz / 64; C = (st & 1) * 32 + (swz % 64) / 2; }
DI int perm32(int rho) { const int n = rho >> 4, i = rho & 15; return 8 * (i >> 2) + 4 * n + (i & 3); }
struct Unit { int pm, pn; };
struct Gemm { const bf16_t* A; const bf16_t* Bt; int M, N, K; };
struct StaticOrder {
    int nM, nN, nwg, G, c;
    DI void init(int M, int N, int G_, int c_) { nM = M / BM; nN = N / BM; nwg = nM * nN; G = G_; c = c_; }
    DI bool next(int i, Unit& u) const {
        const long L = (long)i * G + c; if (L >= nwg) return false;
        int wgid = (int)L; { const int q = nwg / NXCD, r = nwg % NXCD, xcd = wgid % NXCD, off = wgid / NXCD; wgid = (xcd < r ? xcd * (q + 1) : r * (q + 1) + (xcd - r) * q) + off; }
        const int nig = WGM * nN, gid = wgid / nig, fm = gid * WGM, gsz = (nM - fm) < WGM ? (nM - fm) : WGM;
        u.pm = fm + ((wgid % nig) % gsz); u.pn = (wgid % nig) / gsz; return true;
    }
};
template <class Epi>
DI void gemm_phase(LAS unsigned char* lds, const Gemm g, const StaticOrder& S, const Epi& E) {
    const int tid = opaque_tid(), wid = __builtin_amdgcn_readfirstlane(tid >> 6), lane = tid & 63, wr = wid >> 2, wc = wid & 3, fr = lane & 15, fq = lane >> 4;
    const int K = g.K, nt = K / BK;
    unsigned voffA[2], voffB[2];
#pragma unroll
    for (int i = 0; i < 2; ++i) { int R, C; stage_rc(tid * 16 + i * 8192, R, C); const int Rb = (R & ~31) + perm32(R & 31);
        voffA[i] = (unsigned)(R * K + C) * 2u; voffB[i] = (unsigned)(Rb * K + C) * 2u; }
    const size_t kstep = (size_t)(BK * 2);
    const size_t hstep = (size_t)HALF * K * 2;
    const size_t tstep = 2 * hstep;
    const unsigned ldsw = (unsigned)wid * 1024u;
    const int aoff = lds_byte(wr * 64 + fr, fq * 8), boff = lds_byte(wc * 32 + fr, fq * 8);
#define PG8_SA(b, h) (((b) * 2 + (h)) * HTB)
#define PG8_SB(b, h) ((4 + (b) * 2 + (h)) * HTB)
#define PG8_STAGE(bufoff, gbase, voff) do { _Pragma("unroll") for (int _i = 0; _i < 2; ++_i) \
        __builtin_amdgcn_global_load_lds((const unsigned*)((const char*)(gbase) + (voff)[_i]), (LAS unsigned*)(lds + (bufoff) + ldsw + _i * 8192), 16, 0, 0); } while (0)
#define PG8_LDA(dst, b, h) do { _Pragma("unroll") for (int m = 0; m < 4; ++m) _Pragma("unroll") for (int k = 0; k < 2; ++k) dst[m][k] = *(const LAS bf16x8*)(lds + PG8_SA(b, h) + aoff + m * 2048 + k * 1024); } while (0)
#define PG8_LDB(dst, b, h) do { _Pragma("unroll") for (int n = 0; n < 2; ++n) _Pragma("unroll") for (int k = 0; k < 2; ++k) dst[n][k] = *(const LAS bf16x8*)(lds + PG8_SB(b, h) + boff + n * 2048 + k * 1024); } while (0)
#define PG8_MMA(ai, bj, At, Bt) do { __builtin_amdgcn_s_setprio(1); _Pragma("unroll") for (int m = 0; m < 4; ++m) _Pragma("unroll") for (int n = 0; n < 2; ++n) _Pragma("unroll") for (int k = 0; k < 2; ++k) \
        acc[ai][bj][m][n] = __builtin_amdgcn_mfma_f32_16x16x32_bf16(Bt[n][k], At[m][k], acc[ai][bj][m][n], 0, 0, 0); __builtin_amdgcn_s_setprio(0); } while (0)
#define PG8_WAIT_V(n) asm volatile("s_waitcnt vmcnt(" #n ")" ::: "memory")
#define PG8_WAIT_L(n) asm volatile("s_waitcnt lgkmcnt(" #n ")" ::: "memory")
#define PG8_BAR __builtin_amdgcn_s_barrier()
#define PG8_SCHED __builtin_amdgcn_sched_barrier(0)
    Unit cur, nxt; int ui = 0;
    if (!S.next(0, cur)) return;
    f32x4 acc[2][2][4][2];
#pragma unroll
    for (int a = 0; a < 2; ++a)
#pragma unroll
        for (int b = 0; b < 2; ++b)
#pragma unroll
            for (int m = 0; m < 4; ++m)
#pragma unroll
                for (int n = 0; n < 2; ++n) acc[a][b][m][n] = (f32x4){0.f, 0.f, 0.f, 0.f};
    bf16x8 At[4][2], B0[2][2], B1[2][2];
    const char* cA = (const char*)g.A + (size_t)cur.pm * tstep; const char* cB = (const char*)g.Bt + (size_t)cur.pn * tstep;
    PG8_STAGE(PG8_SB(0, 0), cB, voffB); PG8_STAGE(PG8_SA(0, 0), cA, voffA); PG8_STAGE(PG8_SB(0, 1), cB + hstep, voffB); PG8_STAGE(PG8_SA(0, 1), cA + hstep, voffA);
    if (wr == 1) PG8_BAR;
    PG8_WAIT_V(4); PG8_BAR;
    PG8_STAGE(PG8_SB(1, 0), cB + kstep, voffB); PG8_STAGE(PG8_SA(1, 0), cA + kstep, voffA); PG8_STAGE(PG8_SB(1, 1), cB + hstep + kstep, voffB);
    PG8_WAIT_V(6); PG8_BAR;
    for (;;) {
        const bool has_next = S.next(ui + 1, nxt);
        const char* nA = has_next ? (const char*)g.A + (size_t)nxt.pm * tstep : cA; const char* nB = has_next ? (const char*)g.Bt + (size_t)nxt.pn * tstep : cB;
        for (int t = 0; t < nt; t += 2) {
            const bool last = (t == nt - 2);
            const char* a1 = cA + (size_t)(t + 1) * kstep;
            const char* a2 = last ? nA : cA + (size_t)(t + 2) * kstep; const char* b2 = last ? nB : cB + (size_t)(t + 2) * kstep;
            const char* a3 = a2 + kstep; const char* b3 = b2 + kstep;
            PG8_LDB(B0, 0, 0); PG8_SCHED; PG8_LDA(At, 0, 0); PG8_STAGE(PG8_SA(1, 1), a1 + hstep, voffA);
            PG8_WAIT_L(8); PG8_BAR; PG8_WAIT_L(0); PG8_MMA(0, 0, At, B0); PG8_BAR; PG8_SCHED;
            PG8_LDB(B1, 0, 1); PG8_STAGE(PG8_SB(0, 0), b2, voffB);
            PG8_BAR; PG8_WAIT_L(0); PG8_MMA(0, 1, At, B1); PG8_BAR;
            PG8_LDA(At, 0, 1); PG8_STAGE(PG8_SA(0, 0), a2, voffA);
            PG8_BAR; PG8_WAIT_L(0); PG8_MMA(1, 0, At, B0); PG8_BAR; PG8_SCHED;
            PG8_STAGE(PG8_SB(0, 1), b2 + hstep, voffB);
            PG8_WAIT_V(6); PG8_BAR; PG8_MMA(1, 1, At, B1); PG8_BAR;
            PG8_LDB(B0, 1, 0); PG8_SCHED; PG8_LDA(At, 1, 0); PG8_STAGE(PG8_SA(0, 1), a2 + hstep, voffA);
            PG8_WAIT_L(8); PG8_BAR; PG8_WAIT_L(0); PG8_MMA(0, 0, At, B0); PG8_BAR; PG8_SCHED;
            PG8_LDB(B1, 1, 1); PG8_STAGE(PG8_SB(1, 0), b3, voffB);
            PG8_BAR; PG8_WAIT_L(0); PG8_MMA(0, 1, At, B1); PG8_BAR;
            PG8_LDA(At, 1, 1); PG8_STAGE(PG8_SA(1, 0), a3, voffA);
            PG8_BAR; PG8_WAIT_L(0); PG8_MMA(1, 0, At, B0); PG8_BAR; PG8_SCHED;
            PG8_STAGE(PG8_SB(1, 1), b3 + hstep, voffB);
            PG8_WAIT_V(6); PG8_BAR; PG8_MMA(1, 1, At, B1); PG8_BAR;
        }
        E(acc, cur, wr, wc, fr, fq);
        if (!has_next) break;
#pragma unroll
        for (int a = 0; a < 2; ++a)
#pragma unroll
            for (int b = 0; b < 2; ++b)
#pragma unroll
                for (int m = 0; m < 4; ++m)
#pragma unroll
                    for (int n = 0; n < 2; ++n) acc[a][b][m][n] = (f32x4){0.f, 0.f, 0.f, 0.f};
        cur = nxt; cA = nA; cB = nB; ++ui;
    }
    PG8_WAIT_V(0);
    if (wr == 0) PG8_BAR;
    PG8_BAR;
#undef PG8_SA
#undef PG8_SB
#undef PG8_STAGE
#undef PG8_LDA
#undef PG8_LDB
#undef PG8_MMA
#undef PG8_WAIT_V
#undef PG8_WAIT_L
#undef PG8_BAR
#undef PG8_SCHED
}
}
typedef f32x4 Acc[2][2][4][2];

struct EpiIn {
    bf16_t *cq, *kr, *hq, *gf, *gb, *hi, *hg; float *ssq_q, *ssq_kv; const f32x2* rope; const float* lb; int layer;
    DI void operator()(const Acc& acc, const pg8::Unit& u, int wr, int wc, int fr, int fq) const {
        asm volatile("" : "+v"(fr), "+v"(fq));
        const int row0 = u.pm * 256 + wr * 64 + fr, cw = wc * 32 + 8 * fq, pn = u.pn;
        if (pn == 0) {
#pragma unroll
            for (int ai = 0; ai < 2; ++ai)
#pragma unroll
                for (int m = 0; m < 4; ++m) { const int row = row0 + ai * 128 + m * 16; float ss = 0.f;
#pragma unroll
                    for (int bj = 0; bj < 2; ++bj) { const f32x4 v0 = acc[ai][bj][m][0], v1 = acc[ai][bj][m][1];
                        *(u32x4*)(cq + (size_t)row * 384 + bj * 128 + cw) = pk8(v0, v1);
                        ss += v0[0] * v0[0] + v0[1] * v0[1] + v0[2] * v0[2] + v0[3] * v0[3] + v1[0] * v1[0] + v1[1] * v1[1] + v1[2] * v1[2] + v1[3] * v1[3]; }
                    ss += __shfl_xor(ss, 16); ss += __shfl_xor(ss, 32);
                    if (fq == 0) ssq_q[row * 4 + wc] = ss; }
        } else if (pn == 1) {
#pragma unroll
            for (int ai = 0; ai < 2; ++ai)
#pragma unroll
                for (int m = 0; m < 4; ++m) { const int row = row0 + ai * 128 + m * 16;
                    { const f32x4 v0 = acc[ai][0][m][0], v1 = acc[ai][0][m][1];
                      *(u32x4*)(cq + (size_t)row * 384 + 256 + cw) = pk8(v0, v1);
                      float ss = v0[0] * v0[0] + v0[1] * v0[1] + v0[2] * v0[2] + v0[3] * v0[3] + v1[0] * v1[0] + v1[1] * v1[1] + v1[2] * v1[2] + v1[3] * v1[3];
                      ss += __shfl_xor(ss, 16); ss += __shfl_xor(ss, 32);
                      if (fq == 0) ssq_kv[row * 4 + wc] = ss; }
                    if (wc == 0) { const f32x4 x1 = acc[ai][1][m][0], x2 = acc[ai][1][m][1]; const int pos = row & (SEQL - 1); f32x4 o1, o2;
#pragma unroll
                        for (int j = 0; j < 4; ++j) { const f32x2 cs = rope[pos * 16 + 4 * fq + j]; o1[j] = x1[j] * cs.x - x2[j] * cs.y; o2[j] = x2[j] * cs.x + x1[j] * cs.y; }
                        *(u32x4*)(kr + (size_t)row * 32 + 8 * fq) = pk8(o1, o2); }
                    asm volatile("" ::: "memory"); }
        } else {
            const int seg = (pn - 2) >> 1, cb = ((pn - 2) & 1) * 256;
            bf16_t* dst = seg == 0 ? hq : seg == 1 ? gf : seg == 2 ? gb : seg == 3 ? hi : hg;
#pragma unroll
            for (int bj = 0; bj < 2; ++bj) { const int col = cb + bj * 128 + cw;
                f32x4 l0 = {0.f, 0.f, 0.f, 0.f}, l1 = l0;
                if (seg == 1 || seg == 2) { const float* lp = lb + ((seg - 1) * 4 + layer) * 512 + col; l0 = *(const f32x4*)lp; l1 = *(const f32x4*)(lp + 4); }
#pragma unroll
                for (int ai = 0; ai < 2; ++ai)
#pragma unroll
                    for (int m = 0; m < 4; ++m) { const int row = row0 + ai * 128 + m * 16; f32x4 v0 = acc[ai][bj][m][0], v1 = acc[ai][bj][m][1];
                        if (seg == 0 || seg == 4) {
#pragma unroll
                            for (int j = 0; j < 4; ++j) { v0[j] = v0[j] * sigm(v0[j]); v1[j] = v1[j] * sigm(v1[j]); }
                        } else if (seg == 1 || seg == 2) {
#pragma unroll
                            for (int j = 0; j < 4; ++j) { v0[j] = fmaxf(__logf(l0[j] + (1.0f - l0[j]) * sigm(v0[j])), -30.0f); v1[j] = fmaxf(__logf(l1[j] + (1.0f - l1[j]) * sigm(v1[j])), -30.0f); }
                        }
                        *(u32x4*)(dst + (size_t)row * 512 + col) = pk8(v0, v1); } }
        }
    }
};
struct EpiQkv {
    bf16_t *q, *kn, *v; const float *ssq_q, *ssq_kv; const f32x2* rope;
    DI void operator()(const Acc& acc, const pg8::Unit& u, int wr, int wc, int fr, int fq) const {
        asm volatile("" : "+v"(fr), "+v"(fq));
        const int row0 = u.pm * 256 + wr * 64 + fr, cw = wc * 32 + 8 * fq, pn = u.pn;
        const float qsc = 0.10206207261596575f * 1.4426950408889634f;
#pragma unroll
        for (int ai = 0; ai < 2; ++ai)
#pragma unroll
            for (int m = 0; m < 4; ++m) { const int row = row0 + ai * 128 + m * 16;
                if (pn <= 2) { const f32x4 sq4 = *(const f32x4*)(ssq_q + row * 4); const float rq = rsqrtf(((sq4[0] + sq4[1]) + (sq4[2] + sq4[3])) * (1.0f / 256.0f) + EPSN) * qsc;
                    if (pn < 2) {
#pragma unroll
                        for (int bj = 0; bj < 2; ++bj) { const int colg = pn * 256 + bj * 128 + cw, head = colg >> 6, d = colg & 63;
                            *(u32x4*)(q + (size_t)row * 768 + head * 96 + d) = pk8(acc[ai][bj][m][0] * rq, acc[ai][bj][m][1] * rq); }
                    } else { const int pos = row & (SEQL - 1);
#pragma unroll
                        for (int bj = 0; bj < 2; ++bj) { const int head = 4 * bj + wc; const f32x4 x1 = acc[ai][bj][m][0] * rq, x2 = acc[ai][bj][m][1] * rq; f32x4 o1, o2;
#pragma unroll
                            for (int j = 0; j < 4; ++j) { const f32x2 cs = rope[pos * 16 + 4 * fq + j]; o1[j] = x1[j] * cs.x - x2[j] * cs.y; o2[j] = x2[j] * cs.x + x1[j] * cs.y; }
                            *(u32x4*)(q + (size_t)row * 768 + head * 96 + 64 + 8 * fq) = pk8(o1, o2); }
                    }
                } else { const f32x4 sk4 = *(const f32x4*)(ssq_kv + row * 4); const float rk = rsqrtf(((sk4[0] + sk4[1]) + (sk4[2] + sk4[3])) * (1.0f / 128.0f) + EPSN);
                    bf16_t* dst = pn < 5 ? kn : v; const int cb = ((pn - 3) & 1) * 256;
#pragma unroll
                    for (int bj = 0; bj < 2; ++bj) *(u32x4*)(dst + (size_t)row * 512 + cb + bj * 128 + cw) = pk8(acc[ai][bj][m][0] * rk, acc[ai][bj][m][1] * rk);
                }
                asm volatile("" ::: "memory"); }
    }
};
struct EpiT {
    bf16_t* t; float* ssq; const bf16_t* gate;
    DI void operator()(const Acc& acc, const pg8::Unit& u, int wr, int wc, int fr, int fq) const {
        asm volatile("" : "+v"(fr), "+v"(fq));
        const int row0 = u.pm * 256 + wr * 64 + fr, c0 = u.pn * 256 + wc * 32 + 8 * fq;
#pragma unroll
        for (int ai = 0; ai < 2; ++ai)
#pragma unroll
            for (int m = 0; m < 4; ++m) { const int row = row0 + ai * 128 + m * 16; float ss = 0.f;
#pragma unroll
                for (int bj = 0; bj < 2; ++bj) { f32x4 v0 = acc[ai][bj][m][0], v1 = acc[ai][bj][m][1]; const size_t off = (size_t)row * 1024 + c0 + bj * 128;
                    if (gate) { const u32x4 gw = *(const u32x4*)(gate + off);
                        v0[0] *= blo(gw.x); v0[1] *= bhi(gw.x); v0[2] *= blo(gw.y); v0[3] *= bhi(gw.y); v1[0] *= blo(gw.z); v1[1] *= bhi(gw.z); v1[2] *= blo(gw.w); v1[3] *= bhi(gw.w); }
                    *(u32x4*)(t + off) = pk8(v0, v1);
                    ss += v0[0] * v0[0] + v0[1] * v0[1] + v0[2] * v0[2] + v0[3] * v0[3] + v1[0] * v1[0] + v1[1] * v1[1] + v1[2] * v1[2] + v1[3] * v1[3]; }
                ss += __shfl_xor(ss, 16); ss += __shfl_xor(ss, 32);
                if (fq == 0) ssq[row * 16 + u.pn * 4 + wc] = ss;
                asm volatile("" ::: "memory"); }
    }
};
template <int ACT> struct EpiAct {
    bf16_t* o; int ldc;
    DI void operator()(const Acc& acc, const pg8::Unit& u, int wr, int wc, int fr, int fq) const {
        asm volatile("" : "+v"(fr), "+v"(fq));
        const int row0 = u.pm * 256 + wr * 64 + fr, c0 = u.pn * 256 + wc * 32 + 8 * fq;
#pragma unroll
        for (int ai = 0; ai < 2; ++ai)
#pragma unroll
            for (int m = 0; m < 4; ++m) { const int row = row0 + ai * 128 + m * 16;
#pragma unroll
                for (int bj = 0; bj < 2; ++bj) { f32x4 v0 = acc[ai][bj][m][0], v1 = acc[ai][bj][m][1];
#pragma unroll
                    for (int j = 0; j < 4; ++j) {
                        if (ACT == 0) { const float a = fmaxf(v0[j], 0.f), b = fmaxf(v1[j], 0.f); v0[j] = a * a; v1[j] = b * b; }
                        else { v0[j] = sigm(v0[j]); v1[j] = sigm(v1[j]); } }
                    *(u32x4*)(o + (size_t)row * ldc + c0 + bj * 128) = pk8(v0, v1); } }
    }
};

template <class Epi> DI void run_gemm(LAS unsigned char* lds, const bf16_t* A, const bf16_t* Bt, int N, int K, const Epi& E) {
    pg8::Gemm g{A, Bt, MTOK, opaque_s(N), opaque_s(K)}; pg8::StaticOrder S; S.init(MTOK, g.N, opaque_s((int)gridDim.x), opaque_s((int)blockIdx.x));
    pg8::gemm_phase<Epi>(lds, g, S, E);
}

DI int rope_dim(int p) { return 16 * ((p & 7) >> 2) + 4 * (p >> 3) + (p & 3); }
DI int map_in(int n) {
    if (n < 384) return n;
    if (n < 416) return 384 + rope_dim(n - 384);
    if (n < 512) return -1;
    if (n < 1024) return 416 + (n - 512);
    if (n < 1536) return 928 + (n - 1024);
    if (n < 2048) return 1440 + (n - 1536);
    if (n < 2560) return 1952 + (n - 2048);
    return 2464 + (n - 2560);
}
DI float wsrc(const Params& P, int job, int L, int n, int k) {
    switch (job) {
    case 0: { const int c = map_in(n); return c < 0 ? 0.f : __builtin_nontemporal_load(&P.in[5][((size_t)L * 1024 + k) * 2976 + c]) * P.in[4][L * 1024 + k]; }
    case 1: {
        if (n < 768) { if (k >= 256) return 0.f;
            int c; if (n < 512) c = (n >> 6) * 96 + (n & 63); else { const int mm = n - 512; c = (mm >> 5) * 96 + 64 + rope_dim(mm & 31); }
            return __builtin_nontemporal_load(&P.in[7][((size_t)L * 256 + k) * 768 + c]) * P.in[6][L * 256 + k]; }
        if (k < 256) return 0.f;
        const int kk = k - 256; int mm = n - 768, c; if (mm < 512) c = (mm >> 6) * 128 + (mm & 63); else { mm -= 512; c = (mm >> 6) * 128 + 64 + (mm & 63); }
        return __builtin_nontemporal_load(&P.in[9][((size_t)L * 128 + kk) * 1024 + c]) * P.in[8][L * 128 + kk]; }
    case 2: return __builtin_nontemporal_load(&P.in[13][((size_t)L * 1024 + k) * 1024 + n]);
    case 3: return __builtin_nontemporal_load(&P.in[16][((size_t)L * 1024 + k) * 4096 + n]) * P.in[15][L * 1024 + k];
    case 4: return __builtin_nontemporal_load(&P.in[17][((size_t)L * 4096 + k) * 1024 + n]);
    case 5: return __builtin_nontemporal_load(&P.in[20][((size_t)L * 1024 + k) * 1024 + n]);
    default: return __builtin_nontemporal_load(&P.in[19][((size_t)L * 256 + k) * 1024 + n]);
    }
}
DI void prep_weights(const Params& P, LAS unsigned char* lds, int L, unsigned char* wb, int t0, int t1, int tstride) {
    const int tid = opaque_tid();
    LAS bf16_t* tile = (LAS bf16_t*)lds;
    for (int ti = t0; ti < t1; ti += tstride) {
        int job, t = ti, NT, Kout; size_t dst;
        if (t < 768) { job = 0; NT = 48; Kout = 1024; dst = WS_WIN; }
        else if ((t -= 768) < 168) { job = 1; NT = 28; Kout = 384; dst = WS_WQKV; }
        else if ((t -= 168) < 256) { job = 2; NT = 16; Kout = 1024; dst = WS_WO; }
        else if ((t -= 256) < 1024) { job = 3; NT = 64; Kout = 1024; dst = WS_WUP; }
        else if ((t -= 1024) < 1024) { job = 4; NT = 16; Kout = 4096; dst = WS_WDN; }
        else if ((t -= 1024) < 256) { job = 5; NT = 16; Kout = 1024; dst = WS_WGT; }
        else { t -= 256; job = 6; NT = 16; Kout = 256; dst = WS_WPL; }
        const int n0 = (t % NT) * 64, k0 = (t / NT) * 64;
        { const int nn = tid & 63, kk = tid >> 6;
#pragma unroll
          for (int i = 0; i < 8; ++i) { const int k = kk + 8 * i; const float v = wsrc(P, job, L, n0 + nn, k0 + k); tile[nn * 72 + k] = (bf16_t)(pk2(v, 0.f) & 0xffffu); } }
        __syncthreads();
        { const int n = tid >> 3, kc = tid & 7; const u32x4 w = *(const LAS u32x4*)(tile + n * 72 + kc * 8);
          *(u32x4*)((bf16_t*)(wb + dst) + (size_t)(n0 + n) * Kout + k0 + kc * 8) = w; }
        __syncthreads();
    }
}
DI void prep_tables(const Params& P) {
    const int gt = opaque_s(blockIdx.x) * 512 + opaque_tid(), nth = opaque_s(gridDim.x) * 512;
    f32x2* rope = (f32x2*)(P.ws + WS_ROPE);
    for (int idx = gt; idx < 4096 * 16; idx += nth) { const int pos = idx >> 4, i = idx & 15;
        const float inv = exp2f(-(float)i * (13.287712379549449f / 16.0f)); const float a = (float)pos * inv;
        const float n = rintf(a * 0.15915494309189535f); float r = fmaf(-n, 6.2831854820251465f, a); r = fmaf(-n, -1.7484555e-7f, r);
        rope[idx] = (f32x2){__cosf(r), __sinf(r)}; }
    float* lbs = (float*)(P.ws + WS_LB);
    for (int idx = gt; idx < 1024; idx += nth) { const int dir = idx >> 9, col = idx & 511; float v[4], mx = -1e30f, sum = 0.f;
        for (int l = 0; l < 4; ++l) { v[l] = P.in[11][(dir * 4 + l) * 512 + col]; mx = fmaxf(mx, v[l]); }
        for (int l = 0; l < 4; ++l) { v[l] = __expf(v[l] - mx); sum += v[l]; }
        float cum = 0.f; lbs[(dir * 4) * 512 + col] = 0.f;
        for (int l = 1; l < 4; ++l) { cum += v[l] / sum; lbs[(dir * 4 + l) * 512 + col] = cum; } }
    unsigned* cnt = (unsigned*)(P.ws + WS_CNT);
    if (gt < 64) cnt[gt] = 0u;
    unsigned* barw = (unsigned*)(P.ws + WS_BAR);
    for (int idx = gt; idx < XCD_BAR_WORDS_EARLY; idx += nth) barw[idx] = 0u;
}

typedef _Float16 h2_t __attribute__((ext_vector_type(2)));
DI unsigned pkh2(float a, float b) { f32x2 v = {a, b}; return __builtin_bit_cast(unsigned, __builtin_convertvector(v, h2_t)); }
DI f32x2 unh2(unsigned w) { return __builtin_convertvector(__builtin_bit_cast(h2_t, w), f32x2); }
DI void norm_phase(const Params& P, int mode, int layer, const float* gain, const bf16_t* T, bf16_t* out2, int norm_out, int fin = 0, int rev = 0) {
    const int tid_ = opaque_tid(); const int lane = tid_ & 63, gw = opaque_s(blockIdx.x) * 8 + (tid_ >> 6), nw = opaque_s(gridDim.x) * 8;
    const float* ssq_t = (const float*)(P.ws + WS_SSQT);
    bf16_t* pb = (bf16_t*)(P.ws + A_PB);
    unsigned short* X16 = (unsigned short*)(P.ws + A_H);
    constexpr int RU = 2;
    for (int row0 = gw; row0 < MTOK; row0 += RU * nw) {
        f32x4 xv[RU][4]; u32x2 tw[RU][4]; float sq[RU]; f32x4 pv[RU];
#pragma unroll
        for (int r = 0; r < RU; ++r) { const int rrow = row0 + r * nw; const int row = rev ? MTOK - 1 - rrow : rrow; if (rrow < MTOK) {
            if (mode == 0) { const float* xs = row < NPROMPT ? P.in[0] + (size_t)row * 1024 : P.in[1] + (size_t)(row - NPROMPT) * 1024;
#pragma unroll
                for (int i = 0; i < 4; ++i) xv[r][i] = *(const f32x4*)(xs + (i * 64 + lane) * 4);
            } else {
#pragma unroll
                for (int i = 0; i < 4; ++i) { const u32x2 xw = __builtin_nontemporal_load((const u32x2*)(X16 + (size_t)row * 1024 + (i * 64 + lane) * 4)); const f32x2 a = unh2(xw.x), c = unh2(xw.y); xv[r][i] = (f32x4){a.x, a.y, c.x, c.y}; }
                sq[r] = lane < 16 ? ssq_t[row * 16 + lane] : 0.f;
#pragma unroll
                for (int i = 0; i < 4; ++i) tw[r][i] = __builtin_nontemporal_load((const u32x2*)(T + (size_t)row * 1024 + (i * 64 + lane) * 4)); }
            if (mode == 2) { const float* pp = row < NPROMPT ? P.in[2] + ((size_t)layer * NPROMPT + row) * 256 : P.in[3] + ((size_t)layer * (MTOK - NPROMPT) + (row - NPROMPT)) * 256;
                pv[r] = *(const f32x4*)(pp + lane * 4); } } }
#pragma unroll
        for (int r = 0; r < RU; ++r) { const int rrow = row0 + r * nw; const int row = rev ? MTOK - 1 - rrow : rrow; if (rrow < MTOK) {
            if (mode != 0) { const float rs = rsqrtf(wave_sum(sq[r]) * (1.0f / 1024.0f) + EPSN);
#pragma unroll
                for (int i = 0; i < 4; ++i) { const f32x4 g4 = *(const f32x4*)(gain + (i * 64 + lane) * 4);
                    xv[r][i][0] += blo(tw[r][i].x) * rs * g4[0]; xv[r][i][1] += bhi(tw[r][i].x) * rs * g4[1]; xv[r][i][2] += blo(tw[r][i].y) * rs * g4[2]; xv[r][i][3] += bhi(tw[r][i].y) * rs * g4[3]; } }
            if (fin) {
#pragma unroll
                for (int i = 0; i < 4; ++i) *(f32x4*)(P.out + (size_t)row * 1024 + (i * 64 + lane) * 4) = xv[r][i];
            } else {
                float ss = 0.f;
#pragma unroll
                for (int i = 0; i < 4; ++i) ss += xv[r][i][0] * xv[r][i][0] + xv[r][i][1] * xv[r][i][1] + xv[r][i][2] * xv[r][i][2] + xv[r][i][3] * xv[r][i][3];
                ss = wave_sum(ss);
                const float rx = norm_out ? rsqrtf(ss * (1.0f / 1024.0f) + EPSN) : 1.0f;
#pragma unroll
                for (int i = 0; i < 4; ++i) { u32x2 xw; xw.x = pkh2(xv[r][i][0], xv[r][i][1]); xw.y = pkh2(xv[r][i][2], xv[r][i][3]);
                    __builtin_nontemporal_store(xw, (u32x2*)(X16 + (size_t)row * 1024 + (i * 64 + lane) * 4));
                    u32x2 w; w.x = pk2(xv[r][i][0] * rx, xv[r][i][1] * rx); w.y = pk2(xv[r][i][2] * rx, xv[r][i][3] * rx);
                    *(u32x2*)(out2 + (size_t)row * 1024 + (i * 64 + lane) * 4) = w; }
                if (mode == 2) { u32x2 w; w.x = pk2(pv[r][0], pv[r][1]); w.y = pk2(pv[r][2], pv[r][3]); *(u32x2*)(pb + (size_t)row * 256 + lane * 4) = w; } } } }
    }
}
DI void combine_phase(const Params& P, int layer) {
    const int tid_ = opaque_tid(); const int lane = tid_ & 63, gw = opaque_s(blockIdx.x) * 8 + (tid_ >> 6), nw = opaque_s(gridDim.x) * 8;
    const bf16_t* Q = (const bf16_t*)(P.ws + A_Q); bf16_t* H = (bf16_t*)P.out; const bf16_t* HG = (const bf16_t*)(P.ws + A_HG);
    const float* g1 = P.in[10] + layer * 512 + lane * 8; const float* g2 = P.in[12] + layer * 512 + lane * 8;
    const f32x4 ga0 = *(const f32x4*)g1, ga1 = *(const f32x4*)(g1 + 4), gb0 = *(const f32x4*)g2, gb1 = *(const f32x4*)(g2 + 4);
    constexpr int RU = 2;
    for (int row0 = gw; row0 < MTOK; row0 += RU * nw) {
        u32x4 aw[RU], fw[RU], bw[RU], gw4[RU];
#pragma unroll
        for (int r = 0; r < RU; ++r) { const int row = row0 + r * nw; if (row < MTOK) {
            aw[r] = *(const u32x4*)(Q + (size_t)row * 768 + (lane >> 3) * 96 + (lane & 7) * 8);
            fw[r] = *(const u32x4*)(H + (size_t)row * 1024 + lane * 8); bw[r] = *(const u32x4*)(H + (size_t)row * 1024 + 512 + lane * 8);
            gw4[r] = *(const u32x4*)(HG + (size_t)row * 512 + lane * 8); } }
#pragma unroll
        for (int r = 0; r < RU; ++r) { const int row = row0 + r * nw; if (row < MTOK) {
            f32x4 a0 = {blo(aw[r].x), bhi(aw[r].x), blo(aw[r].y), bhi(aw[r].y)}, a1 = {blo(aw[r].z), bhi(aw[r].z), blo(aw[r].w), bhi(aw[r].w)};
            f32x4 o0 = {blo(fw[r].x) + blo(bw[r].x), bhi(fw[r].x) + bhi(bw[r].x), blo(fw[r].y) + blo(bw[r].y), bhi(fw[r].y) + bhi(bw[r].y)};
            f32x4 o1 = {blo(fw[r].z) + blo(bw[r].z), bhi(fw[r].z) + bhi(bw[r].z), blo(fw[r].w) + blo(bw[r].w), bhi(fw[r].w) + bhi(bw[r].w)};
            float sa = a0[0] * a0[0] + a0[1] * a0[1] + a0[2] * a0[2] + a0[3] * a0[3] + a1[0] * a1[0] + a1[1] * a1[1] + a1[2] * a1[2] + a1[3] * a1[3];
            float so = o0[0] * o0[0] + o0[1] * o0[1] + o0[2] * o0[2] + o0[3] * o0[3] + o1[0] * o1[0] + o1[1] * o1[1] + o1[2] * o1[2] + o1[3] * o1[3];
            sa = wave_sum(sa);
            so += __shfl_xor(so, 1); so += __shfl_xor(so, 2); so += __shfl_xor(so, 4); so += __shfl_xor(so, 8);
            const float ra = rsqrtf(sa * (1.0f / 512.0f) + EPSN), ro = rsqrtf(so * (1.0f / 128.0f) + EPSN);
            const f32x4 h0 = {blo(gw4[r].x), bhi(gw4[r].x), blo(gw4[r].y), bhi(gw4[r].y)}, h1 = {blo(gw4[r].z), bhi(gw4[r].z), blo(gw4[r].w), bhi(gw4[r].w)};
            *(u32x4*)(H + (size_t)row * 1024 + lane * 8) = pk8(a0 * ra * ga0, a1 * ra * ga1);
            *(u32x4*)(H + (size_t)row * 1024 + 512 + lane * 8) = pk8(o0 * ro * gb0 * h0, o1 * ro * gb1 * h1); } }
    }
}

template <bool SAFE> DI bool attn_item(const Params& P, LAS unsigned char* lds, int b, int head, int qblk, bool do_store = true) {
    const int tid = opaque_tid(), lane = tid & 63, wid = __builtin_amdgcn_readfirstlane(tid >> 6), l31 = lane & 31, hh = lane >> 5;
    bf16_t* Qg = (bf16_t*)(P.ws + A_Q); const bf16_t* KN = (const bf16_t*)(P.ws + A_KN); const bf16_t* KR = (const bf16_t*)(P.ws + A_KR); const bf16_t* Vg = (const bf16_t*)(P.ws + A_V);
    const size_t seq0 = (size_t)b * SEQL;
    const size_t qrow = seq0 + qblk * 256 + wid * 32 + l31;
    bf16x8 bq[6];
    { const bf16_t* qp = Qg + qrow * 768 + head * 96 + 8 * hh;
#pragma unroll
      for (int s = 0; s < 6; ++s) bq[s] = *(const bf16x8*)(qp + 16 * s); }
    f32x16 o0, o1;
#pragma unroll
    for (int i = 0; i < 16; ++i) { o0[i] = 0.f; o1[i] = 0.f; }
    float mrun = -1e30f, lsum = 0.f;
    const int kkey = tid >> 3, kc = tid & 7, rkey = (tid & 255) >> 2, rc = tid & 3;
    const bf16_t* kn_g = KN + (seq0 + kkey) * 512 + head * 64 + kc * 8;
    const bf16_t* kr_g = KR + (seq0 + rkey) * 32 + rc * 8;
    const bf16_t* v_g = Vg + (seq0 + kkey) * 512 + head * 64 + kc * 8;
    const int trq = (lane & 15) >> 2, trp = lane & 3, trd = 16 * ((lane >> 4) & 1);
    u32x4 rk = *(const u32x4*)kn_g, rr = *(const u32x4*)kr_g, rv = *(const u32x4*)v_g;
#define ATT_KS(buf) ((LAS bf16_t*)(lds + (buf) * 13312))
#define ATT_VT(buf) ((LAS bf16_t*)(lds + 26624 + (buf) * 12288))
#define ATT_WRITE(buf) do { \
        *(LAS u32x4*)(ATT_KS(buf) + kkey * 104 + kc * 8) = rk; \
        if (tid < 256) *(LAS u32x4*)(ATT_KS(buf) + rkey * 104 + 64 + rc * 8) = rr; \
        *(LAS u32x4*)(ATT_VT(buf) + kkey * 96 + kc * 8) = rv; } while (0)
    ATT_WRITE(0);
    __syncthreads();
#pragma unroll 1
    for (int t = 0; t < 64; ++t) {
        const int cur = t & 1;
        if (t + 1 < 64) { const size_t adv = (size_t)(t + 1) * 64;
            rk = *(const u32x4*)(kn_g + adv * 512); rr = *(const u32x4*)(kr_g + adv * 32); rv = *(const u32x4*)(v_g + adv * 512); }
        const LAS bf16_t* Ks = ATT_KS(cur); const LAS bf16_t* Vt = ATT_VT(cur);
        f32x16 s0, s1;
#pragma unroll
        for (int i = 0; i < 16; ++i) { s0[i] = 0.f; s1[i] = 0.f; }
        bf16x8 ka0[6], ka1[6];
#pragma unroll
        for (int s = 0; s < 6; ++s) { ka0[s] = *(const LAS bf16x8*)(Ks + l31 * 104 + 16 * s + 8 * hh); ka1[s] = *(const LAS bf16x8*)(Ks + (32 + l31) * 104 + 16 * s + 8 * hh); }
        __builtin_amdgcn_sched_barrier(0);
#pragma unroll
        for (int s = 0; s < 6; ++s) { s0 = MFMA32(ka0[s], bq[s], s0); s1 = MFMA32(ka1[s], bq[s], s1); }
        typedef short s16x4 __attribute__((ext_vector_type(4)));
        bf16x8 vf0[4], vf1[4];
#pragma unroll
        for (int f = 0; f < 4; ++f) { const int keyb = 32 * (f >> 1) + 16 * (f & 1) + 4 * hh;
            { const s16x4 lo = __builtin_amdgcn_ds_read_tr16_b64_v4i16((LAS s16x4*)(Vt + (keyb + trq) * 96 + trd + 4 * trp)), hi = __builtin_amdgcn_ds_read_tr16_b64_v4i16((LAS s16x4*)(Vt + (keyb + 8 + trq) * 96 + trd + 4 * trp));
              vf0[f] = __builtin_shufflevector(lo, hi, 0, 1, 2, 3, 4, 5, 6, 7); }
            { const s16x4 lo = __builtin_amdgcn_ds_read_tr16_b64_v4i16((LAS s16x4*)(Vt + (keyb + trq) * 96 + 32 + trd + 4 * trp)), hi = __builtin_amdgcn_ds_read_tr16_b64_v4i16((LAS s16x4*)(Vt + (keyb + 8 + trq) * 96 + 32 + trd + 4 * trp));
              vf1[f] = __builtin_shufflevector(lo, hi, 0, 1, 2, 3, 4, 5, 6, 7); } }
        __builtin_amdgcn_sched_barrier(0);
        if (SAFE) {
            float mx = s0[0];
#pragma unroll
            for (int i = 1; i < 16; ++i) mx = fmaxf(mx, s0[i]);
#pragma unroll
            for (int i = 0; i < 16; ++i) mx = fmaxf(mx, s1[i]);
            mx = fmaxf(mx, __shfl_xor(mx, 32));
            const float mnew = fmaxf(mrun, mx), alpha = __builtin_amdgcn_exp2f(mrun - mnew); mrun = mnew;
            float ps = 0.f;
#pragma unroll
            for (int i = 0; i < 16; ++i) { s0[i] = __builtin_amdgcn_exp2f(s0[i] - mnew); s1[i] = __builtin_amdgcn_exp2f(s1[i] - mnew); ps += s0[i] + s1[i]; }
            lsum = lsum * alpha + ps;
#pragma unroll
            for (int i = 0; i < 16; ++i) { o0[i] *= alpha; o1[i] *= alpha; }
        } else {
            float ps = 0.f;
#pragma unroll
            for (int i = 0; i < 16; ++i) { s0[i] = __builtin_amdgcn_exp2f(s0[i]); s1[i] = __builtin_amdgcn_exp2f(s1[i]); ps += s0[i] + s1[i]; }
            lsum += ps;
        }
#pragma unroll
        for (int kb = 0; kb < 2; ++kb)
#pragma unroll
            for (int sg = 0; sg < 2; ++sg) {
                u32x4 pw;
                if (kb == 0) { pw.x = pk2(s0[8 * sg + 0], s0[8 * sg + 1]); pw.y = pk2(s0[8 * sg + 2], s0[8 * sg + 3]); pw.z = pk2(s0[8 * sg + 4], s0[8 * sg + 5]); pw.w = pk2(s0[8 * sg + 6], s0[8 * sg + 7]); }
                else { pw.x = pk2(s1[8 * sg + 0], s1[8 * sg + 1]); pw.y = pk2(s1[8 * sg + 2], s1[8 * sg + 3]); pw.z = pk2(s1[8 * sg + 4], s1[8 * sg + 5]); pw.w = pk2(s1[8 * sg + 6], s1[8 * sg + 7]); }
                const bf16x8 pb = __builtin_bit_cast(bf16x8, pw);
                o0 = MFMA32(vf0[2 * kb + sg], pb, o0); o1 = MFMA32(vf1[2 * kb + sg], pb, o1);
            }
        if (t + 1 < 64) ATT_WRITE(cur ^ 1);
        __syncthreads();
    }
    lsum += __shfl_xor(lsum, 32);
    if (!SAFE) { const int bad = !(lsum > 1e-30f && lsum < 1e30f); if (__syncthreads_or(bad)) return true; }
    const float inv = 1.0f / lsum;
    bf16_t* op = do_store ? Qg + qrow * 768 + head * 96 + 4 * hh : (bf16_t*)(P.ws + A_CQ) + qrow * 384 + (head & 3) * 64 + 4 * hh;
#pragma unroll
    for (int g = 0; g < 4; ++g) {
        u32x2 w0, w1;
        w0.x = pk2(o0[4 * g] * inv, o0[4 * g + 1] * inv); w0.y = pk2(o0[4 * g + 2] * inv, o0[4 * g + 3] * inv);
        w1.x = pk2(o1[4 * g] * inv, o1[4 * g + 1] * inv); w1.y = pk2(o1[4 * g + 2] * inv, o1[4 * g + 3] * inv);
        *(u32x2*)(op + 8 * g) = w0; *(u32x2*)(op + 32 + 8 * g) = w1;
    }
#undef ATT_KS
#undef ATT_VT
#undef ATT_WRITE
    return false;
}

DI void hgrn_chain(const Params& P, LAS unsigned char* lds, int b, int head, int dir) {
    typedef short s16x4 __attribute__((ext_vector_type(4)));
    const int tid = opaque_tid(), lane = tid & 63, wid = __builtin_amdgcn_readfirstlane(tid >> 6), l31 = lane & 31, hh = lane >> 5;
#define HB(buf) (lds + (buf) * 38400)
    const bf16_t* gq = (const bf16_t*)(P.ws + A_HQ); const bf16_t* gg = (const bf16_t*)(P.ws + (dir ? A_GB : A_GF)); const bf16_t* gv = (const bf16_t*)(P.ws + A_HI);
    bf16_t* go = (bf16_t*)P.out + (dir ? 512 : 0);
    const size_t seq0 = (size_t)b * SEQL;
#define HG_TOK(c, tau) (dir ? (SEQL - 1 - ((c) * 32 + (tau))) : ((c) * 32 + (tau)))
#define HG_BAR() do { asm volatile("s_waitcnt lgkmcnt(0)" ::: "memory"); __builtin_amdgcn_s_barrier(); asm volatile("" ::: "memory"); } while (0)
    if (wid < 4) {
        const int kp16 = lane & 15, part = lane >> 4, k0 = 2 * (16 * wid + kp16), vt = tid & 31, vc = tid >> 5;
        unsigned rg[8], rq[8]; u32x4 rv0, rv1;
#define HG_LOAD(c1, G, Q, V0, V1) do { \
            _Pragma("unroll") for (int t_ = 0; t_ < 8; ++t_) { const size_t a_ = (seq0 + HG_TOK(c1, 8 * part + t_)) * 512 + head * 128 + k0; G[t_] = *(const unsigned*)(gg + a_); Q[t_] = *(const unsigned*)(gq + a_); } \
            { const bf16_t* vp_ = gv + (seq0 + HG_TOK(c1, vt)) * 512 + head * 128 + 16 * vc; V0 = *(const u32x4*)vp_; V1 = *(const u32x4*)(vp_ + 8); } } while (0)
        HG_LOAD(0, rg, rq, rv0, rv1);
#pragma unroll 1
        for (int c1 = 0; c1 < 128; ++c1) {
            unsigned ng[8], nq[8]; u32x4 nv0, nv1;
            if (c1 + 1 < 128) HG_LOAD(c1 + 1, ng, nq, nv0, nv1);
            LAS unsigned char* hb = HB(c1 & 1);
            LAS bf16_t* Qt = (LAS bf16_t*)hb; LAS bf16_t* Kt = (LAS bf16_t*)(hb + 8704); LAS bf16_t* KdT = (LAS bf16_t*)(hb + 17408); LAS bf16_t* Vs = (LAS bf16_t*)(hb + 27648); LAS float* dec = (LAS float*)(hb + 37888);
            float csA[8], csB[8], tA = 0.f, tB = 0.f;
#pragma unroll
            for (int i = 0; i < 8; ++i) { tA += blo(rg[i]); tB += bhi(rg[i]); csA[i] = tA; csB[i] = tB; }
            float offA = 0.f, offB = 0.f, totA = 0.f, totB = 0.f;
#pragma unroll
            for (int pp = 0; pp < 4; ++pp) { const float a_ = __shfl(tA, kp16 + 16 * pp), b_ = __shfl(tB, kp16 + 16 * pp); totA += a_; totB += b_; offA += (pp < part) ? a_ : 0.f; offB += (pp < part) ? b_ : 0.f; }
            float kdA[8], kdB[8];
#pragma unroll
            for (int i = 0; i < 8; ++i) {
                const float bA = offA + csA[i], bB = offB + csB[i];
                const float eA = __expf(bA), eB = __expf(bB), kkA = 1.0f - __expf(blo(rg[i])), kkB = 1.0f - __expf(bhi(rg[i]));
                const int tau = 8 * part + i;
                *(LAS unsigned*)(Qt + tau * 136 + k0) = pk2(blo(rq[i]) * eA, bhi(rq[i]) * eB);
                *(LAS unsigned*)(Kt + tau * 136 + k0) = pk2(kkA * __expf(fminf(-bA, 80.0f)), kkB * __expf(fminf(-bB, 80.0f)));
                kdA[i] = kkA * __expf(totA - bA); kdB[i] = kkB * __expf(totB - bB);
            }
            { u32x4 w0, w1; w0.x = pk2(kdA[0], kdA[1]); w0.y = pk2(kdA[2], kdA[3]); w0.z = pk2(kdA[4], kdA[5]); w0.w = pk2(kdA[6], kdA[7]);
              w1.x = pk2(kdB[0], kdB[1]); w1.y = pk2(kdB[2], kdB[3]); w1.z = pk2(kdB[4], kdB[5]); w1.w = pk2(kdB[6], kdB[7]);
              *(LAS u32x4*)(KdT + k0 * 40 + 8 * part) = w0; *(LAS u32x4*)(KdT + (k0 + 1) * 40 + 8 * part) = w1; }
            if (part == 0) { dec[k0] = __expf(totA); dec[k0 + 1] = __expf(totB); }
            *(LAS u32x4*)(Vs + vt * 160 + 16 * vc) = rv0; *(LAS u32x4*)(Vs + vt * 160 + 16 * vc + 8) = rv1;
            if (c1 + 1 < 128) {
#pragma unroll
                for (int t_ = 0; t_ < 8; ++t_) { rg[t_] = ng[t_]; rq[t_] = nq[t_]; }
                rv0 = nv0; rv1 = nv1; }
            HG_BAR();
        }
        HG_BAR();
#undef HG_LOAD
    } else {
        const int vb = wid - 4;
        const int trq = (lane & 15) >> 2, trp = lane & 3, trd = 16 * ((lane >> 4) & 1);
        f32x16 X0, X1, X2, X3;
#pragma unroll
        for (int i = 0; i < 16; ++i) { X0[i] = 0.f; X1[i] = 0.f; X2[i] = 0.f; X3[i] = 0.f; }
        HG_BAR();
#pragma unroll 1
        for (int c = 0; c < 128; ++c) {
            const LAS unsigned char* hb = HB(c & 1);
            const LAS bf16_t* Qt = (const LAS bf16_t*)hb; const LAS bf16_t* Kt = (const LAS bf16_t*)(hb + 8704); const LAS bf16_t* KdT = (const LAS bf16_t*)(hb + 17408); const LAS bf16_t* Vs = (const LAS bf16_t*)(hb + 27648); const LAS float* dec = (const LAS float*)(hb + 37888);
            f32x16 pt, O;
#pragma unroll
            for (int i = 0; i < 16; ++i) { pt[i] = 0.f; O[i] = 0.f; }
#pragma unroll
            for (int ks = 0; ks < 8; ++ks) { const bf16x8 a = *(const LAS bf16x8*)(Kt + l31 * 136 + 16 * ks + 8 * hh), bqv = *(const LAS bf16x8*)(Qt + l31 * 136 + 16 * ks + 8 * hh); pt = MFMA32(a, bqv, pt); }
#define HG_SQ(X, kb) do { _Pragma("unroll") for (int sg = 0; sg < 2; ++sg) { u32x4 xw; xw.x = pk2(X[8 * sg], X[8 * sg + 1]); xw.y = pk2(X[8 * sg + 2], X[8 * sg + 3]); xw.z = pk2(X[8 * sg + 4], X[8 * sg + 5]); xw.w = pk2(X[8 * sg + 6], X[8 * sg + 7]); \
                const LAS bf16_t* qp_ = Qt + l31 * 136 + 32 * (kb) + 16 * sg + 4 * hh; const u32x2 lo_ = *(const LAS u32x2*)qp_, hi_ = *(const LAS u32x2*)(qp_ + 8); \
                const u32x4 bw_ = {lo_.x, lo_.y, hi_.x, hi_.y}; O = MFMA32(__builtin_bit_cast(bf16x8, xw), __builtin_bit_cast(bf16x8, bw_), O); } } while (0)
            HG_SQ(X0, 0); HG_SQ(X1, 1); HG_SQ(X2, 2); HG_SQ(X3, 3);
#undef HG_SQ
#pragma unroll
            for (int r = 0; r < 16; ++r) { const int srow = (r & 3) + 8 * (r >> 2) + 4 * hh; pt[r] = (srow <= l31) ? pt[r] : 0.f; }
#pragma unroll
            for (int sg = 0; sg < 2; ++sg) { u32x4 pw; pw.x = pk2(pt[8 * sg], pt[8 * sg + 1]); pw.y = pk2(pt[8 * sg + 2], pt[8 * sg + 3]); pw.z = pk2(pt[8 * sg + 4], pt[8 * sg + 5]); pw.w = pk2(pt[8 * sg + 6], pt[8 * sg + 7]);
                const LAS bf16_t* vp = Vs + (16 * sg + 4 * hh + trq) * 160 + 32 * vb + trd + 4 * trp;
                const s16x4 lo = __builtin_amdgcn_ds_read_tr16_b64_v4i16((LAS s16x4*)vp), hi = __builtin_amdgcn_ds_read_tr16_b64_v4i16((LAS s16x4*)(vp + 8 * 160));
                O = MFMA32(__builtin_shufflevector(lo, hi, 0, 1, 2, 3, 4, 5, 6, 7), __builtin_bit_cast(bf16x8, pw), O); }
            bf16x8 vfr[2];
#pragma unroll
            for (int sg = 0; sg < 2; ++sg) { const LAS bf16_t* vp = Vs + (16 * sg + 8 * hh + trq) * 160 + 32 * vb + trd + 4 * trp;
                const s16x4 lo = __builtin_amdgcn_ds_read_tr16_b64_v4i16((LAS s16x4*)vp), hi = __builtin_amdgcn_ds_read_tr16_b64_v4i16((LAS s16x4*)(vp + 4 * 160));
                vfr[sg] = __builtin_shufflevector(lo, hi, 0, 1, 2, 3, 4, 5, 6, 7); }
#define HG_UP(X, kb) do { _Pragma("unroll") for (int g = 0; g < 4; ++g) { const f32x4 d4 = *(const LAS f32x4*)(dec + 32 * (kb) + 8 * g + 4 * hh); \
                    X[4 * g] *= d4[0]; X[4 * g + 1] *= d4[1]; X[4 * g + 2] *= d4[2]; X[4 * g + 3] *= d4[3]; } \
                _Pragma("unroll") for (int sg = 0; sg < 2; ++sg) { const bf16x8 a_ = *(const LAS bf16x8*)(KdT + (32 * (kb) + l31) * 40 + 16 * sg + 8 * hh); X = MFMA32(a_, vfr[sg], X); } } while (0)
            HG_UP(X0, 0); HG_UP(X1, 1); HG_UP(X2, 2); HG_UP(X3, 3);
#undef HG_UP
            { bf16_t* op = go + (seq0 + HG_TOK(c, l31)) * 1024 + head * 128 + 32 * vb + 4 * hh;
#pragma unroll
              for (int g = 0; g < 4; ++g) { u32x2 w; w.x = pk2(O[4 * g], O[4 * g + 1]); w.y = pk2(O[4 * g + 2], O[4 * g + 3]); *(u32x2*)(op + 8 * g) = w; } }
            HG_BAR();
        }
    }
#undef HB
#undef HG_TOK
#undef HG_BAR
}

DI void mixer_phase(const Params& P, LAS unsigned char* lds, int layer, unsigned char* wnext, int probe = 0) {
    unsigned* cnt = (unsigned*)(P.ws + WS_CNT) + (probe ? layer + 4 : layer) * 8;
    LAS unsigned* slot = (LAS unsigned*)(lds + 131072);
    const int xq0 = opaque_s(blockIdx.x) & 7;
    for (int rr = 0; rr < 8; ++rr) {
        const int xq = (xq0 + rr) & 7;
        for (;;) {
            if (threadIdx.x == 0) *slot = atomicAdd(cnt + xq, 1u);
            __syncthreads();
            const unsigned i = *slot;
            __syncthreads();
            if (i >= 204u) { if (wnext == nullptr || probe != 0 || i >= 268u) break;
                const int pi = xq * 64 + (int)(i - 204u);
                prep_weights(P, lds, layer + 1, wnext, pi * 7, (pi * 7 + 7) < 3560 ? (pi * 7 + 7) : 3560, 1);
                continue; }
            if (i < 12u) { if (probe != 2) { const int ci = xq * 12 + (int)i; hgrn_chain(P, lds, ci >> 3, (ci >> 1) & 3, ci & 1); } }
            else { if (probe != 1) { const int j = (int)i - 12, pair = xq * 12 + (j >> 4); if (attn_item<false>(P, lds, pair >> 3, pair & 7, j & 15, probe == 0)) { __syncthreads(); attn_item<true>(P, lds, pair >> 3, pair & 7, j & 15, probe == 0); } } }
            __syncthreads();
        }
    }
}


#define XB_TMO      128
#define XB_XCNT(j)  (256  + 64 * (j))
#define XB_XSUB(j)  (1280 + 64 * (j))
#define XB_XGEN(j)  (2304 + 64 * (j))
#define XB_TOP      3328
#define XB_TOPGEN   3392
#define XCD_BAR_WORDS 3456
#define XB_SPIN_CAP (1u << 18)
DI unsigned xb_ld(unsigned* p) { return __hip_atomic_load(p, __ATOMIC_RELAXED, __HIP_MEMORY_SCOPE_AGENT); }
DI unsigned xb_add(unsigned* p, unsigned v) { return __hip_atomic_fetch_add(p, v, __ATOMIC_RELAXED, __HIP_MEMORY_SCOPE_AGENT); }
DI unsigned xb_xcc_id() { return (unsigned)__builtin_amdgcn_s_getreg((3 << 11) | 20) & 0xFu; }
#define XB_SPIN(cond, bar) do { unsigned _sp = 0; while (cond) { __builtin_amdgcn_s_sleep(1); \
    if ((++_sp & 255u) == 0u) { if (xb_ld(&(bar)[XB_TMO])) break; if (_sp > XB_SPIN_CAP) { atomicAdd(&(bar)[XB_TMO], 1u); break; } } } } while (0)
struct XcdBarrier { unsigned* bar; unsigned x; volatile LAS unsigned* st; };
DI XcdBarrier xcd_barrier_post(unsigned* bar, volatile LAS unsigned* st) {
    XcdBarrier b; b.bar = bar; b.x = xb_xcc_id(); b.st = st;
    if (threadIdx.x == 0) (void)xb_add(&bar[XB_XCNT(b.x)], 1u);
    return b;
}
DI void xcd_barrier_complete(unsigned* bar, unsigned x, unsigned& nloc, unsigned& nx) {
    const unsigned G = gridDim.x * gridDim.y * gridDim.z;
    unsigned sum, cnt, mine, sp = 0u;
    for (;;) {
        sum = 0u; cnt = 0u; mine = 0u;
#pragma unroll
        for (unsigned j = 0; j < 16; ++j) { const unsigned c = xb_ld(&bar[XB_XCNT(j)]); sum += c; cnt += (c > 0u) ? 1u : 0u; mine = (j == x) ? c : mine; }
        if (sum == G) break;
        __builtin_amdgcn_s_sleep(1);
        if ((++sp & 255u) == 0u) { if (xb_ld(&bar[XB_TMO])) break; if (sp > XB_SPIN_CAP) { atomicAdd(&bar[XB_TMO], 1u); break; } }
    }
    nloc = mine > 0u ? mine : 1u; nx = cnt > 0u ? cnt : 1u;
}
DI void xcd_barrier(const XcdBarrier& b) {
    asm volatile("s_waitcnt vmcnt(0)" ::: "memory");
    __syncthreads();
    if (threadIdx.x == 0) {
        unsigned* bar = b.bar;
        __builtin_amdgcn_s_waitcnt(0);
        unsigned nloc = b.st[0], nx = b.st[1];
        if (nloc == 0u) { xcd_barrier_complete(bar, b.x, nloc, nx); b.st[0] = nloc; b.st[1] = nx; }
        const unsigned old = xb_add(&bar[XB_XSUB(b.x)], 1u);
        const unsigned gen = old / nloc;
        if (old + 1u == (gen + 1u) * nloc) {
            __builtin_amdgcn_fence(__ATOMIC_RELEASE, "agent");
            asm volatile("s_waitcnt vmcnt(0)" ::: "memory");
            const unsigned og = xb_add(&bar[XB_TOP], 1u);
            const unsigned tg = og / nx;
            if (og + 1u == (tg + 1u) * nx) xb_add(&bar[XB_TOPGEN], 1u);
            else XB_SPIN(xb_ld(&bar[XB_TOPGEN]) == tg, bar);
            __builtin_amdgcn_fence(__ATOMIC_ACQUIRE, "agent");
            xb_add(&bar[XB_XGEN(b.x)], 1u);
            asm volatile("s_waitcnt vmcnt(0)" ::: "memory");
        } else {
            XB_SPIN(xb_ld(&bar[XB_XGEN(b.x)]) == gen, bar);
            __builtin_amdgcn_fence(__ATOMIC_ACQUIRE, "agent");
            asm volatile("s_waitcnt vmcnt(0)" ::: "memory");
        }
    }
    __syncthreads();
}

__global__ void __launch_bounds__(512) fwd_kernel(Params P) {
    extern __shared__ __attribute__((aligned(16))) unsigned char shm[];
    LAS unsigned char* lds = (LAS unsigned char*)shm;
    cg::grid_group grid = cg::this_grid();
    unsigned char* ws = P.ws;
    bf16_t* H = (bf16_t*)P.out;
    float* ssq_t = (float*)(ws + WS_SSQT); float* ssq_q = (float*)(ws + WS_SSQQ); float* ssq_k = (float*)(ws + WS_SSQK);
    const f32x2* rope = (const f32x2*)(ws + WS_ROPE);

    volatile LAS unsigned* xst = (volatile LAS unsigned*)(lds + 131072 + 16);
    if (threadIdx.x < 2) xst[threadIdx.x] = 0u;
    __syncthreads();
    prep_tables(P);
    norm_phase(P, 0, 0, nullptr, nullptr, H, 1);
    unsigned char* const wimg1 = (unsigned char*)P.out + (size_t)MTOK * 2048;
    prep_weights(P, lds, 0, ws, opaque_s(blockIdx.x), 3560, opaque_s(gridDim.x));
    grid.sync();
    const XcdBarrier xb = xcd_barrier_post((unsigned*)(ws + WS_BAR), xst);
#define GSYNC() xcd_barrier(xb)
#pragma unroll 1
    for (int layer = 0; layer < 4; ++layer) {
        if (layer > 0) GSYNC();
        const unsigned char* wb = (layer & 1) ? wimg1 : ws;
        unsigned char* wnext = layer < 3 ? ((layer & 1) ? ws : wimg1) : nullptr;
        { EpiIn E{(bf16_t*)(ws + A_CQ), (bf16_t*)(ws + A_KR), (bf16_t*)(ws + A_HQ), (bf16_t*)(ws + A_GF), (bf16_t*)(ws + A_GB), (bf16_t*)(ws + A_HI), (bf16_t*)(ws + A_HG),
                  ssq_q, ssq_k, rope, (const float*)(ws + WS_LB), layer};
          run_gemm(lds, H, (const bf16_t*)(wb + WS_WIN), 3072, 1024, E); }
        GSYNC();
        { EpiQkv E{(bf16_t*)(ws + A_Q), (bf16_t*)(ws + A_KN), (bf16_t*)(ws + A_V), ssq_q, ssq_k, rope};
          run_gemm(lds, (const bf16_t*)(ws + A_CQ), (const bf16_t*)(wb + WS_WQKV), 1792, 384, E); }
        GSYNC();
#ifdef PROBE_DUP
        mixer_phase(P, lds, layer, nullptr, PROBE_DUP);
        GSYNC();
#endif
        mixer_phase(P, lds, layer, wnext);
        GSYNC();
        combine_phase(P, layer);
        GSYNC();
        { EpiT E{(bf16_t*)(ws + A_T1), ssq_t, nullptr};
          run_gemm(lds, H, (const bf16_t*)(wb + WS_WO), 1024, 1024, E); }
        GSYNC();
        norm_phase(P, 1, layer, P.in[14] + layer * 1024, (const bf16_t*)(ws + A_T1), H, 1, 0, (1 + layer * 3) & 1);
        GSYNC();
        { EpiAct<0> E{(bf16_t*)(ws + A_U), 4096};
          run_gemm(lds, H, (const bf16_t*)(wb + WS_WUP), 4096, 1024, E); }
        GSYNC();
        { EpiT E{H, ssq_t, nullptr};
          run_gemm(lds, (const bf16_t*)(ws + A_U), (const bf16_t*)(wb + WS_WDN), 1024, 4096, E); }
        GSYNC();
        norm_phase(P, 2, layer, P.in[18] + layer * 1024, H, H, 0, 0, (2 + layer * 3) & 1);
        GSYNC();
        { EpiAct<1> E{(bf16_t*)(ws + A_G), 1024};
          run_gemm(lds, H, (const bf16_t*)(wb + WS_WGT), 1024, 1024, E); }
        GSYNC();
        bf16_t* Tl = layer < 3 ? H : (bf16_t*)(ws + A_V);
        { EpiT E{Tl, ssq_t, (const bf16_t*)(ws + A_G)};
          run_gemm(lds, (const bf16_t*)(ws + A_PB), (const bf16_t*)(wb + WS_WPL), 1024, 256, E); }
        GSYNC();
        norm_phase(P, 3, layer, P.in[21] + layer * 1024, Tl, H, 1, layer == 3, (3 + layer * 3) & 1);
    }
}

extern "C" void kernel_launch(void* const* d_in, const int* in_sizes, int n_in, void* d_out, int out_size, void* d_ws, size_t ws_size, hipStream_t stream) {
    static int grid_blocks = 0;
    if (grid_blocks == 0) {
        if (n_in != 22 || out_size != MTOK * 1024 || ws_size < WS_END) { fprintf(stderr, "kernel_launch: unexpected shapes (n_in %d out %d ws %zu need %zu)\n", n_in, out_size, ws_size, (size_t)WS_END); grid_blocks = -1; return; }
        int dev = 0, cus = 0, per_cu = 0;
        hipGetDevice(&dev);
        hipDeviceGetAttribute(&cus, hipDeviceAttributeMultiprocessorCount, dev);
        if (hipFuncSetAttribute((const void*)fwd_kernel, hipFuncAttributeMaxDynamicSharedMemorySize, LDS_BYTES) != hipSuccess) { fprintf(stderr, "kernel_launch: hipFuncSetAttribute failed\n"); grid_blocks = -1; return; }
        hipOccupancyMaxActiveBlocksPerMultiprocessor(&per_cu, (const void*)fwd_kernel, 512, LDS_BYTES);
        if (per_cu < 1) { fprintf(stderr, "kernel_launch: occupancy query says %d blocks/CU\n", per_cu); per_cu = 1; }
        (void)hipGetLastError();
        grid_blocks = cus;
    }
    if (grid_blocks < 0) return;
    Params p{};
    for (int i = 0; i < 22; ++i) p.in[i] = (const float*)d_in[i];
    p.out = (float*)d_out; p.ws = (unsigned char*)d_ws;
    void* args[] = {&p};
    hipError_t e = hipLaunchCooperativeKernel((const void*)fwd_kernel, dim3(grid_blocks), dim3(512), args, LDS_BYTES, stream);
    if (e != hipSuccess) fprintf(stderr, "cooperative launch failed: %s (grid %d)\n", hipGetErrorString(e), grid_blocks);
}
```
